# Optimizing an MI355X kernel written in HIP

```python
import math
import jax, jax.numpy as jnp
from jax import lax
import numpy as np

D_MODEL = 1024
BATCH = 16
SEQ = 256
DEPTH = 2
DEC_BATCH = 8
DEC_SEQ = 1024
PAST_LEN = 512

GRID_W = 64
N_MIXERS = 2
N_ATTN_LAYERS = (DEPTH + 1) // 2
N_RET_LAYERS = DEPTH // 2
N_HEADS = 8
N_KV_HEADS = 2
HEAD_DIM = D_MODEL // N_HEADS
GROUP = N_HEADS // N_KV_HEADS
ROPE_BASE = 10000.0
Q_BLOCK = 128
RET_HEADS = 4
RET_DK = D_MODEL // RET_HEADS
RET_DV = D_MODEL // RET_HEADS
RET_CHUNK = 128
D_FF = 4 * D_MODEL
EPS = 1e-6

kernel_name = 'hybrid_flow_gqa_retention_prefix_step'


def rms_norm(x, g):
    x32 = x.astype(jnp.float32)
    y = x32 * lax.rsqrt(jnp.mean(x32 * x32, axis=-1, keepdims=True) + EPS)
    return (y * g.astype(jnp.float32)).astype(x.dtype)


def adaln_params(cond, w, b):
    m = (jax.nn.silu(cond) @ w + b)[:, None, :]
    return jnp.split(m, 6, axis=-1)


def modulate(h, shift, scale):
    return h * (1.0 + scale) + shift


def axial_rope(x):
    n, d = x.shape[1], x.shape[-1]
    quarter = d // 4
    n_rows = n // GRID_W
    rows = jnp.broadcast_to(jnp.arange(n_rows)[:, None], (n_rows, GRID_W)).reshape(-1)
    cols = jnp.broadcast_to(jnp.arange(GRID_W)[None, :], (n_rows, GRID_W)).reshape(-1)
    freqs = ROPE_BASE ** (-jnp.arange(quarter, dtype=jnp.float32) / quarter)
    ang = jnp.stack([rows.astype(jnp.float32)[:, None] * freqs,
                     cols.astype(jnp.float32)[:, None] * freqs], axis=1)
    cos = jnp.cos(ang)[None, :, None]
    sin = jnp.sin(ang)[None, :, None]
    xs = x.astype(jnp.float32).reshape(x.shape[:-1] + (2, 2, quarter))
    x1 = xs[..., 0, :]
    x2 = xs[..., 1, :]
    out = jnp.stack([x1 * cos - x2 * sin, x2 * cos + x1 * sin], axis=-2)
    return out.reshape(x.shape).astype(x.dtype)


def attn_qkv(h, w_qkv, q_norm, k_norm, use_rope):
    b, n, _ = h.shape
    qkv = h @ w_qkv
    nq = N_HEADS * HEAD_DIM
    nk = N_KV_HEADS * HEAD_DIM
    q = qkv[..., :nq].reshape(b, n, N_HEADS, HEAD_DIM)
    k = qkv[..., nq:nq + nk].reshape(b, n, N_KV_HEADS, HEAD_DIM)
    v = qkv[..., nq + nk:].reshape(b, n, N_KV_HEADS, HEAD_DIM)
    q = rms_norm(q, q_norm)
    k = rms_norm(k, k_norm)
    if use_rope:
        q = axial_rope(q)
        k = axial_rope(k)
    return q, k, v


def block_attention(q, k, v):
    b, nq = q.shape[:2]
    nb = nq // Q_BLOCK
    qb = q.reshape(b, nb, Q_BLOCK, N_KV_HEADS, GROUP, HEAD_DIM).transpose(1, 0, 2, 3, 4, 5)
    scale = HEAD_DIM ** -0.5
    k32 = k.astype(jnp.float32)
    v32 = v.astype(jnp.float32)

    def one_block(qi):
        s = jnp.einsum('bqkgd,bskd->bkgqs', qi.astype(jnp.float32), k32) * scale
        p = jax.nn.softmax(s, axis=-1)
        return jnp.einsum('bkgqs,bskd->bqkgd', p, v32).astype(q.dtype)

    o = lax.map(one_block, qb)
    return o.transpose(1, 0, 2, 3, 4, 5).reshape(b, nq, N_HEADS * HEAD_DIM)


def retention_chunkwise(q, k, v, log_gamma, s0, strict):
    b, h, n, dk = q.shape
    dv = v.shape[-1]
    nc = n // RET_CHUNK
    idx = jnp.arange(RET_CHUNK, dtype=jnp.float32)
    diff = idx[:, None] - idx[None, :]
    mask = (diff > 0) if strict else (diff >= 0)
    lg = log_gamma.astype(jnp.float32)
    decay_mask = jnp.where(mask[None], jnp.exp(lg[:, None, None] * jnp.where(mask, diff, 0.0)[None]), 0.0)
    q_decay = jnp.exp(lg[:, None] * (idx + 1.0)[None])
    k_decay = jnp.exp(lg[:, None] * (RET_CHUNK - 1.0 - idx)[None])
    chunk_decay = jnp.exp(lg * RET_CHUNK)

    def to_chunks(x):
        return x.astype(jnp.float32).reshape(b, h, nc, RET_CHUNK, x.shape[-1]).transpose(2, 0, 1, 3, 4)

    def step(s, inp):
        qc, kc, vc = inp
        scores = jnp.einsum('bhid,bhjd->bhij', qc, kc) * decay_mask[None]
        intra = jnp.einsum('bhij,bhjv->bhiv', scores, vc)
        inter = jnp.einsum('bhid,bhdv->bhiv', qc, s) * q_decay[None, :, :, None]
        s_new = s * chunk_decay[None, :, None, None] + jnp.einsum(
            'bhjd,bhjv->bhdv', kc * k_decay[None, :, :, None], vc)
        return s_new, intra + inter

    s_fin, o = lax.scan(step, s0.astype(jnp.float32), (to_chunks(q), to_chunks(k), to_chunks(v)))
    o = o.transpose(1, 2, 0, 3, 4).reshape(b, h, n, dv)
    return o, s_fin


def retention_mixer(h, w_qkvg, decay_logit, gn_w, w_o, s0_fwd, s0_bwd, use_rope):
    b, n, _ = h.shape
    proj = h @ w_qkvg
    dk_tot = RET_HEADS * RET_DK
    dv_tot = RET_HEADS * RET_DV
    q = proj[..., :dk_tot].reshape(b, n, RET_HEADS, RET_DK)
    k = proj[..., dk_tot:2 * dk_tot].reshape(b, n, RET_HEADS, RET_DK)
    v = proj[..., 2 * dk_tot:2 * dk_tot + dv_tot].reshape(b, n, RET_HEADS, RET_DV)
    g = proj[..., 2 * dk_tot + dv_tot:]
    if use_rope:
        q = axial_rope(q)
        k = axial_rope(k)
    q = q * (RET_DK ** -0.5)
    q = q.transpose(0, 2, 1, 3)
    k = k.transpose(0, 2, 1, 3)
    v = v.transpose(0, 2, 1, 3)
    log_gamma = jax.nn.log_sigmoid(decay_logit.astype(jnp.float32))
    o_f, s_f = retention_chunkwise(q, k, v, log_gamma[0], s0_fwd, False)
    o_b, s_b = retention_chunkwise(jnp.flip(q, 2), jnp.flip(k, 2), jnp.flip(v, 2),
                                   log_gamma[1], s0_bwd, True)
    o = o_f + jnp.flip(o_b, 2)
    mu = jnp.mean(o, axis=-1, keepdims=True)
    var = jnp.mean(jnp.square(o - mu), axis=-1, keepdims=True)
    o = (o - mu) * lax.rsqrt(var + EPS)
    o = o.transpose(0, 2, 1, 3).reshape(b, n, dv_tot) * gn_w.astype(jnp.float32)
    out = (jax.nn.silu(g) * o.astype(h.dtype)) @ w_o
    return out, s_f, s_b


def sq_relu_mlp(h, w1, w2):
    return jnp.square(jax.nn.relu(h @ w1)) @ w2


def setup_inputs(seed: int = 0) -> dict:
    key = jax.random.key(seed)
    ks = jax.random.split(key, 24)
    f32 = jnp.float32
    D = D_MODEL
    qkv_w = (N_HEADS + 2 * N_KV_HEADS) * HEAD_DIM
    ret_w = 2 * RET_HEADS * RET_DK + 2 * RET_HEADS * RET_DV
    gamma = 1.0 - 2.0 ** (-5.0 - jnp.arange(RET_HEADS, dtype=f32))
    base_logit = jnp.log(gamma) - jnp.log1p(-gamma)
    return {
        'x_prompt': jax.random.normal(ks[0], (BATCH, SEQ, D), f32),
        'x_sample': jax.random.normal(ks[1], (DEC_BATCH, DEC_SEQ, D), f32),
        'cache_k': jax.random.normal(ks[2], (DEC_BATCH, N_ATTN_LAYERS, PAST_LEN, N_KV_HEADS, HEAD_DIM), f32),
        'cache_v': jax.random.normal(ks[3], (DEC_BATCH, N_ATTN_LAYERS, PAST_LEN, N_KV_HEADS, HEAD_DIM), f32),
        'state_ret': 2.0 * jax.random.normal(ks[4], (DEC_BATCH, N_RET_LAYERS, 2, RET_HEADS, RET_DK, RET_DV), f32),
        'c': jax.random.normal(ks[5], (DEC_BATCH, D), f32),
        'c_ctx': jax.random.normal(ks[6], (D,), f32),
        'w_mod': 0.5 * D ** -0.5 * jax.random.normal(ks[7], (DEPTH, D, 6 * D), f32),
        'b_mod': 0.02 * jax.random.normal(ks[8], (DEPTH, 6 * D), f32),
        'norm_g': 1.0 + 0.02 * jax.random.normal(ks[9], (DEPTH, 2, D), f32),
        'attn_w_qkv': D ** -0.5 * jax.random.normal(ks[10], (N_ATTN_LAYERS, D, qkv_w), f32),
        'attn_q_norm': 1.0 + 0.02 * jax.random.normal(ks[11], (N_ATTN_LAYERS, HEAD_DIM), f32),
        'attn_k_norm': 1.0 + 0.02 * jax.random.normal(ks[12], (N_ATTN_LAYERS, HEAD_DIM), f32),
        'attn_w_o': D ** -0.5 * jax.random.normal(ks[13], (N_ATTN_LAYERS, N_HEADS * HEAD_DIM, D), f32),
        'ret_w_qkvg': D ** -0.5 * jax.random.normal(ks[14], (N_RET_LAYERS, D, ret_w), f32),
        'ret_decay_logit': base_logit[None, None, :] + 0.1 * jax.random.normal(ks[15], (N_RET_LAYERS, 2, RET_HEADS), f32),
        'ret_gn_w': 1.0 + 0.02 * jax.random.normal(ks[16], (N_RET_LAYERS, RET_HEADS * RET_DV), f32),
        'ret_w_o': (RET_HEADS * RET_DV) ** -0.5 * jax.random.normal(ks[17], (N_RET_LAYERS, RET_HEADS * RET_DV, D), f32),
        'mlp_w1': D ** -0.5 * jax.random.normal(ks[18], (DEPTH, D, D_FF), f32),
        'mlp_w2': D_FF ** -0.5 * jax.random.normal(ks[19], (DEPTH, D_FF, D), f32),
        'final_norm_g': 1.0 + 0.02 * jax.random.normal(ks[20], (D,), f32),
    }


def reference(x_prompt, x_sample, cache_k, cache_v, state_ret, c, c_ctx,
              w_mod, b_mod, norm_g, attn_w_qkv, attn_q_norm, attn_k_norm, attn_w_o,
              ret_w_qkvg, ret_decay_logit, ret_gn_w, ret_w_o, mlp_w1, mlp_w2, final_norm_g):
    xp = x_prompt
    xs = x_sample
    new_k, new_v, new_s = [], [], []
    for i in range(DEPTH):
        mc = adaln_params(c_ctx[None, :], w_mod[i], b_mod[i])
        ms = adaln_params(c, w_mod[i], b_mod[i])
        hp = modulate(rms_norm(xp, norm_g[i, 0]), mc[0], mc[1])
        hs = modulate(rms_norm(xs, norm_g[i, 0]), ms[0], ms[1])
        j = i // N_MIXERS
        if i % N_MIXERS == 0:
            qp, kp, vp = attn_qkv(hp, attn_w_qkv[j], attn_q_norm[j], attn_k_norm[j], False)
            op = block_attention(qp, kp, vp) @ attn_w_o[j]
            new_k.append(kp)
            new_v.append(vp)
            qs, ks_, vs = attn_qkv(hs, attn_w_qkv[j], attn_q_norm[j], attn_k_norm[j], True)
            k_all = jnp.concatenate([cache_k[:, j].astype(ks_.dtype), ks_], axis=1)
            v_all = jnp.concatenate([cache_v[:, j].astype(vs.dtype), vs], axis=1)
            os_ = block_attention(qs, k_all, v_all) @ attn_w_o[j]
        else:
            zero = jnp.zeros((xp.shape[0], RET_HEADS, RET_DK, RET_DV), jnp.float32)
            op, sf, sb = retention_mixer(hp, ret_w_qkvg[j], ret_decay_logit[j], ret_gn_w[j], ret_w_o[j],
                                         zero, zero, False)
            new_s.append(jnp.stack([sf, sb], axis=1))
            os_, _, _ = retention_mixer(hs, ret_w_qkvg[j], ret_decay_logit[j], ret_gn_w[j], ret_w_o[j],
                                        state_ret[:, j, 0], state_ret[:, j, 1], True)
        xp = xp + mc[2] * op
        xs = xs + ms[2] * os_
        hp = modulate(rms_norm(xp, norm_g[i, 1]), mc[3], mc[4])
        hs = modulate(rms_norm(xs, norm_g[i, 1]), ms[3], ms[4])
        xp = xp + mc[5] * sq_relu_mlp(hp, mlp_w1[i], mlp_w2[i])
        xs = xs + ms[5] * sq_relu_mlp(hs, mlp_w1[i], mlp_w2[i])
    y_prompt = rms_norm(xp, final_norm_g)
    y_sample = rms_norm(xs, final_norm_g)
    new_cache_k = jnp.stack(new_k, axis=1)
    new_cache_v = jnp.stack(new_v, axis=1)
    new_state_ret = jnp.stack(new_s, axis=1)
    return (y_prompt, y_sample, new_cache_k, new_cache_v, new_state_ret)
```

```cpp
#include <hip/hip_runtime.h>
#include <cstdio>
#include <cstdint>

constexpr int DM = 1024, FFD = 4096;
constexpr int NB_CTX = 16, S_CTX = 256, NB_LAT = 8, S_LAT = 1024, PAST = 512;
constexpr int M_CTX = NB_CTX * S_CTX;
constexpr int M_LAT = NB_LAT * S_LAT;
constexpr int MTOK = M_CTX + M_LAT;
constexpr int NQKV = 1536, NRETP = 4096;
constexpr int NCOND = 9;
constexpr int KVL = PAST + S_LAT;
constexpr float EPS = 1e-6f;
constexpr int NWAVES = 8;

constexpr size_t MiB = 1u << 20;
constexpr size_t WS_CTL = 0, CTL_ZERO_BYTES = 2 * MiB;
constexpr size_t CTL_MODACC = 64 * 1024;
constexpr size_t CTL_BIAS = 512 * 1024;
constexpr size_t CTL_ROWSQ = 1 * MiB;
constexpr size_t WS_SMALL = 2 * MiB;
constexpr size_t SM_TABA = 0;
constexpr size_t SM_TABR = 512 * 1024;
constexpr size_t SM_GS = 1536 * 1024;
constexpr size_t SM_QNP = SM_GS + 2 * 2 * 9 * 1024 * 4;
constexpr size_t WS_RETWO = 4 * MiB, WS_W1_1 = 6 * MiB, WS_W2_1 = 14 * MiB;
constexpr size_t WS_WQKV = 22 * MiB, WS_WO = 25 * MiB, WS_W1_0 = 27 * MiB, WS_W2_0 = 35 * MiB, WS_RETW = 43 * MiB;
constexpr size_t WS_A = 51 * MiB, WS_Q = 75 * MiB, WS_KC = 99 * MiB, WS_VC = 101 * MiB, WS_KL = 103 * MiB, WS_VL = 109 * MiB;
constexpr size_t WS_STC = 22 * MiB, WS_STL = 38 * MiB;
constexpr size_t WS_HFF = 115 * MiB, WS_RQ = 115 * MiB, WS_RK = 139 * MiB, WS_RV = 163 * MiB, WS_RG = 187 * MiB;
constexpr size_t WS_RO = 211 * MiB, WS_END = 235 * MiB;
static_assert(WS_RK == WS_RQ + 24 * MiB && WS_RV == WS_RK + 24 * MiB && WS_RG == WS_RV + 24 * MiB && WS_STL + 64 * MiB <= WS_HFF && WS_VL + 6 * MiB <= WS_HFF && WS_RG + 24 * MiB <= WS_RO, "d_ws map");
constexpr int CW_BAR = 4096;

constexpr int RING_BYTES = 131072;
constexpr int LDSCTL_OFF = RING_BYTES, MISC_OFF = LDSCTL_OFF + 320;
constexpr int XCH_OFF = RING_BYTES + 1024;
constexpr int LDS_BYTES = XCH_OFF + 16384;

#define GAS __attribute__((address_space(1)))
#define LAS __attribute__((address_space(3)))
typedef unsigned short bf16;
typedef unsigned v4u __attribute__((ext_vector_type(4)));
typedef unsigned v2u __attribute__((ext_vector_type(2)));
typedef float f32x4 __attribute__((ext_vector_type(4)));
typedef float f32x2 __attribute__((ext_vector_type(2)));
typedef float f32x16 __attribute__((ext_vector_type(16)));
typedef short bf16x8 __attribute__((ext_vector_type(8)));
typedef short s16x4 __attribute__((ext_vector_type(4)));
typedef GAS unsigned gu32;
typedef GAS unsigned long long gu64;
#define RLX_AGENT __ATOMIC_RELAXED, __HIP_MEMORY_SCOPE_AGENT
#define LDS_WAIT() asm volatile("s_waitcnt lgkmcnt(0)" ::: "memory")
#define VM_WAIT() asm volatile("s_waitcnt vmcnt(0)" ::: "memory")
__device__ __forceinline__ unsigned f2bf(float f) { unsigned u = __builtin_bit_cast(unsigned, f); return (u + 0x7fffu + ((u >> 16) & 1u)) >> 16; }
__device__ __forceinline__ unsigned pk2(float lo, float hi) { return f2bf(lo) | (f2bf(hi) << 16); }
__device__ __forceinline__ float bf2f(unsigned short b) { return __builtin_bit_cast(float, ((unsigned)b) << 16); }
__device__ __forceinline__ unsigned cvtpk(float lo, float hi) { unsigned r; asm volatile("v_cvt_pk_bf16_f32 %0, %1, %2" : "=v"(r) : "v"(lo), "v"(hi)); return r; }

__host__ __device__ __forceinline__ int posA(int d) { const int half = d >> 6, m = (d >> 5) & 1, i = d & 31; return 2 * (half * 32 + i) + m; }
__host__ __device__ __forceinline__ int dimA(int p) { const int q = p >> 1, m = p & 1, half = q >> 5, i = q & 31; return half * 64 + m * 32 + i; }
__host__ __device__ __forceinline__ int posR(int d) { const int half = d >> 7, m = (d >> 6) & 1, i = d & 63; return 2 * (half * 64 + i) + m; }
__host__ __device__ __forceinline__ int dimR(int p) { const int q = p >> 1, m = p & 1, half = q >> 6, i = q & 63; return half * 128 + m * 64 + i; }
namespace pg8 {
#define PG8_LAS __attribute__((address_space(3)))
typedef unsigned short bf16_t;
typedef short bf16x8 __attribute__((ext_vector_type(8)));
typedef float f32x4 __attribute__((ext_vector_type(4)));
typedef unsigned u32x4 __attribute__((ext_vector_type(4)));
constexpr int BM = 256, BK = 64, HALF = 128, HTB = HALF * BK * 2  , STAGE_BYTES = 8 * HTB, NXCD = 8, WGM = 8;

__host__ __device__ __forceinline__ int lds_byte(int r, int c) { const int st = (r >> 4) * 2 + (c >> 5), rr = r & 15, cc = c & 31, ob = rr * 64 + cc * 2; return st * 1024 + (ob ^ (((ob >> 9) & 1) << 5)); }
__host__ __device__ __forceinline__ void stage_rc(int b, int& R, int& C) { const int st = b / 1024, sb = b % 1024, swz = sb ^ (((sb >> 9) & 1) << 5); R = (st >> 1) * 16 + swz / 64; C = (st & 1) * 32 + (swz % 64) / 2; }
__host__ __device__ __forceinline__ int perm32(int rho) { const int n = rho >> 4, i = rho & 15; return 8 * (i >> 2) + 4 * n + (i & 3); }

struct Unit { int pm, pn; };
struct Gemm { const bf16_t* A; const bf16_t* Bt; int M, N, K; };

struct StaticOrder {
    int nM, nN, nwg, G, c;
    __host__ __device__ void init(int M, int N, int G_, int c_) { nM = M / BM; nN = N / BM; nwg = nM * nN; G = G_; c = c_; }
    __host__ __device__ bool next(int i, Unit& u) const {
        const long L = (long)i * G + c; if (L >= nwg) return false;
        int wgid = (int)L; { const int q = nwg / NXCD, r = nwg % NXCD, xcd = wgid % NXCD, off = wgid / NXCD; wgid = (xcd < r ? xcd * (q + 1) : r * (q + 1) + (xcd - r) * q) + off; }
        const int nig = WGM * nN, gid = wgid / nig, fm = gid * WGM, gsz = (nM - fm) < WGM ? (nM - fm) : WGM;
        u.pm = fm + ((wgid % nig) % gsz); u.pn = (wgid % nig) / gsz; return true;
    }
    __device__ __forceinline__ void a_ready(const Unit&) const {}
    __device__ __forceinline__ void done(const Unit&) const {}
};
__device__ __forceinline__ unsigned cvt_pk_bf16(float lo, float hi) { unsigned r; asm volatile("v_cvt_pk_bf16_f32 %0, %1, %2" : "=v"(r) : "v"(lo), "v"(hi)); return r; }

template <class Epi, class Sched, bool ALIGN_EPI = false, bool SP2 = false>
__device__ __forceinline__ void gemm_phase(PG8_LAS unsigned char* lds, const Gemm g, const Sched& S, const Epi& E) {
    const int tid = threadIdx.x, wid = __builtin_amdgcn_readfirstlane(tid >> 6), lane = tid & 63, wr = wid >> 2, wc = wid & 3, fr = lane & 15, fq = lane >> 4;
    const int K = g.K, nt = K / BK;
    unsigned voffA[2], voffB[2];
#pragma unroll
    for (int i = 0; i < 2; ++i) { int R, C; stage_rc(tid * 16 + i * 8192, R, C); const int Rb = Epi::PERM ? ((R & ~31) + perm32(R & 31)) : R;
        voffA[i] = (unsigned)(R * K + C) * 2u; voffB[i] = (unsigned)(Rb * K + C) * 2u; }
    const size_t kstep = (size_t)(BK * 2);
    const size_t hstep = (size_t)HALF * K * 2;
    const size_t tstep = 2 * hstep;
    const unsigned ldsw = (unsigned)wid * 1024u;
    const int aoff = lds_byte(wr * 64 + fr, fq * 8), boff = lds_byte(wc * 32 + fr, fq * 8);
#define PG8_SA(b, h) (((b) * 2 + (h)) * HTB)
#define PG8_SB(b, h) ((4 + (b) * 2 + (h)) * HTB)
#define PG8_STAGE(bufoff, gbase, voff) do { _Pragma("unroll") for (int _i = 0; _i < 2; ++_i) \
        __builtin_amdgcn_global_load_lds((const unsigned*)((const char*)(gbase) + (voff)[_i]), (PG8_LAS unsigned*)(lds + (bufoff) + ldsw + _i * 8192), 16, 0, 0); } while (0)
#define PG8_LDA(dst, b, h) do { _Pragma("unroll") for (int m = 0; m < 4; ++m) _Pragma("unroll") for (int k = 0; k < 2; ++k) dst[m][k] = *(const PG8_LAS bf16x8*)(lds + PG8_SA(b, h) + aoff + m * 2048 + k * 1024); } while (0)
#define PG8_LDB(dst, b, h) do { _Pragma("unroll") for (int n = 0; n < 2; ++n) _Pragma("unroll") for (int k = 0; k < 2; ++k) dst[n][k] = *(const PG8_LAS bf16x8*)(lds + PG8_SB(b, h) + boff + n * 2048 + k * 1024); } while (0)
#define PG8_MMA(ai, bj, At, Bt) do { __builtin_amdgcn_s_setprio(1); _Pragma("unroll") for (int m = 0; m < 4; ++m) _Pragma("unroll") for (int n = 0; n < 2; ++n) _Pragma("unroll") for (int k = 0; k < 2; ++k) \
        acc[ai][bj][m][n] = __builtin_amdgcn_mfma_f32_16x16x32_bf16(Bt[n][k], At[m][k], acc[ai][bj][m][n], 0, 0, 0); __builtin_amdgcn_s_setprio(0); } while (0)
#define PG8_WAIT_V(n) asm volatile("s_waitcnt vmcnt(" #n ")" ::: "memory")
#define PG8_WAIT_L(n) asm volatile("s_waitcnt lgkmcnt(" #n ")" ::: "memory")
#define PG8_BAR __builtin_amdgcn_s_barrier()
#define PG8_SCHED __builtin_amdgcn_sched_barrier(0)
    Unit cur, nxt; int ui = 0;
    if (!S.next(0, cur)) return;
    f32x4 acc[2][2][4][2];
#pragma unroll
    for (int a = 0; a < 2; ++a)
#pragma unroll
        for (int b = 0; b < 2; ++b)
#pragma unroll
            for (int m = 0; m < 4; ++m)
#pragma unroll
                for (int n = 0; n < 2; ++n) acc[a][b][m][n] = (f32x4){0.f, 0.f, 0.f, 0.f};
    bf16x8 At[4][2], B0[2][2], B1[2][2];
    const char* cA = (const char*)g.A + (size_t)cur.pm * tstep; const char* cB = (const char*)g.Bt + (size_t)cur.pn * tstep;
    S.a_ready(cur);
    if constexpr (SP2) {
        PG8_STAGE(PG8_SB(0, 0), cB, voffB); PG8_STAGE(PG8_SB(0, 1), cB + hstep, voffB); PG8_STAGE(PG8_SA(0, 0), cA, voffA); PG8_STAGE(PG8_SA(0, 1), cA + hstep, voffA);
        if (wr == 1) PG8_BAR;
        PG8_WAIT_V(2); PG8_BAR;
        PG8_STAGE(PG8_SB(1, 0), cB + kstep, voffB); PG8_STAGE(PG8_SA(1, 0), cA + kstep, voffA); PG8_STAGE(PG8_SB(1, 1), cB + hstep + kstep, voffB);
        PG8_WAIT_V(6); PG8_BAR;
    } else {
        PG8_STAGE(PG8_SB(0, 0), cB, voffB); PG8_STAGE(PG8_SA(0, 0), cA, voffA); PG8_STAGE(PG8_SB(0, 1), cB + hstep, voffB); PG8_STAGE(PG8_SA(0, 1), cA + hstep, voffA);
        if (wr == 1) PG8_BAR;
        PG8_WAIT_V(4); PG8_BAR;
        PG8_STAGE(PG8_SB(1, 0), cB + kstep, voffB); PG8_STAGE(PG8_SA(1, 0), cA + kstep, voffA); PG8_STAGE(PG8_SB(1, 1), cB + hstep + kstep, voffB);
        PG8_WAIT_V(6); PG8_BAR;
    }
    for (;;) {
        const bool has_next = S.next(ui + 1, nxt);
        const char* nA = has_next ? (const char*)g.A + (size_t)nxt.pm * tstep : cA; const char* nB = has_next ? (const char*)g.Bt + (size_t)nxt.pn * tstep : cB;
        for (int t = 0; t < nt; t += 2) {
            const bool last = (t == nt - 2);
            const char* a1 = cA + (size_t)(t + 1) * kstep;
            const char* a2 = last ? nA : cA + (size_t)(t + 2) * kstep; const char* b2 = last ? nB : cB + (size_t)(t + 2) * kstep;
            const char* a3 = a2 + kstep; const char* b3 = b2 + kstep;
            if (last && has_next) S.a_ready(nxt);
            if constexpr (SP2) {
            PG8_LDB(B0, 0, 0); PG8_LDB(B1, 0, 1); PG8_SCHED; PG8_LDA(At, 0, 0); PG8_STAGE(PG8_SA(1, 1), a1 + hstep, voffA);
            PG8_WAIT_V(8); PG8_WAIT_L(0); PG8_BAR; PG8_MMA(0, 0, At, B0); PG8_MMA(0, 1, At, B1); PG8_BAR; PG8_SCHED;
            PG8_LDA(At, 0, 1); PG8_STAGE(PG8_SB(0, 0), b2, voffB); PG8_STAGE(PG8_SB(0, 1), b2 + hstep, voffB); PG8_STAGE(PG8_SA(0, 0), a2, voffA);
            PG8_WAIT_V(8); PG8_WAIT_L(0); PG8_BAR; PG8_MMA(1, 0, At, B0); PG8_MMA(1, 1, At, B1); PG8_BAR; PG8_SCHED;
            PG8_LDB(B0, 1, 0); PG8_LDB(B1, 1, 1); PG8_SCHED; PG8_LDA(At, 1, 0); PG8_STAGE(PG8_SA(0, 1), a2 + hstep, voffA);
            PG8_WAIT_V(8); PG8_WAIT_L(0); PG8_BAR; PG8_MMA(0, 0, At, B0); PG8_MMA(0, 1, At, B1); PG8_BAR; PG8_SCHED;
            PG8_LDA(At, 1, 1); PG8_STAGE(PG8_SB(1, 0), b3, voffB); PG8_STAGE(PG8_SB(1, 1), b3 + hstep, voffB); PG8_STAGE(PG8_SA(1, 0), a3, voffA);
            PG8_WAIT_V(8); PG8_WAIT_L(0); PG8_BAR; PG8_MMA(1, 0, At, B0); PG8_MMA(1, 1, At, B1); PG8_BAR; PG8_SCHED;
            } else {
            PG8_LDB(B0, 0, 0); PG8_SCHED; PG8_LDA(At, 0, 0); PG8_STAGE(PG8_SA(1, 1), a1 + hstep, voffA);
            PG8_WAIT_L(8); PG8_BAR; PG8_WAIT_L(0); PG8_MMA(0, 0, At, B0); PG8_BAR; PG8_SCHED;
            PG8_LDB(B1, 0, 1); PG8_STAGE(PG8_SB(0, 0), b2, voffB);
            PG8_BAR; PG8_WAIT_L(0); PG8_MMA(0, 1, At, B1); PG8_BAR;
            PG8_LDA(At, 0, 1); PG8_STAGE(PG8_SA(0, 0), a2, voffA);
            PG8_BAR; PG8_WAIT_L(0); PG8_MMA(1, 0, At, B0); PG8_BAR; PG8_SCHED;
            PG8_STAGE(PG8_SB(0, 1), b2 + hstep, voffB);
            PG8_WAIT_V(6); PG8_BAR; PG8_MMA(1, 1, At, B1); PG8_BAR;
            PG8_LDB(B0, 1, 0); PG8_SCHED; PG8_LDA(At, 1, 0); PG8_STAGE(PG8_SA(0, 1), a2 + hstep, voffA);
            PG8_WAIT_L(8); PG8_BAR; PG8_WAIT_L(0); PG8_MMA(0, 0, At, B0); PG8_BAR; PG8_SCHED;
            PG8_LDB(B1, 1, 1); PG8_STAGE(PG8_SB(1, 0), b3, voffB);
            PG8_BAR; PG8_WAIT_L(0); PG8_MMA(0, 1, At, B1); PG8_BAR;
            PG8_LDA(At, 1, 1); PG8_STAGE(PG8_SA(1, 0), a3, voffA);
            PG8_BAR; PG8_WAIT_L(0); PG8_MMA(1, 0, At, B0); PG8_BAR; PG8_SCHED;
            PG8_STAGE(PG8_SB(1, 1), b3 + hstep, voffB);
            PG8_WAIT_V(6); PG8_BAR; PG8_MMA(1, 1, At, B1); PG8_BAR;
            }
        }
        if constexpr (ALIGN_EPI) { if (wr == 0) PG8_BAR; }
        if constexpr (!Epi::AFTER_DRAIN) { E(acc, cur, wr, wc, fr, fq, ui); S.done(cur); }
        if (!has_next) break;
#pragma unroll
        for (int a = 0; a < 2; ++a)
#pragma unroll
            for (int b = 0; b < 2; ++b)
#pragma unroll
                for (int m = 0; m < 4; ++m)
#pragma unroll
                    for (int n = 0; n < 2; ++n) acc[a][b][m][n] = (f32x4){0.f, 0.f, 0.f, 0.f};
        cur = nxt; cA = nA; cB = nB; ++ui;
        if constexpr (ALIGN_EPI) { if (wr == 1) PG8_BAR; }
    }
    PG8_WAIT_V(0);
    if constexpr (!ALIGN_EPI) { if (wr == 0) PG8_BAR; }
    PG8_BAR;
    if constexpr (Epi::AFTER_DRAIN) { E.fused(acc, cur, wr, wc, fr, fq, lds, wid, lane); S.done(cur); }
#undef PG8_SA
#undef PG8_SB
#undef PG8_STAGE
#undef PG8_LDA
#undef PG8_LDB
#undef PG8_MMA
#undef PG8_WAIT_V
#undef PG8_WAIT_L
#undef PG8_BAR
#undef PG8_SCHED
}
}
#define XB_TMO      128
#define XB_XCNT(j)  (256  + 64 * (j))
#define XB_XSUB(j)  (1280 + 64 * (j))
#define XB_XGEN(j)  (2304 + 64 * (j))
#define XB_TOP      3328
#define XB_TOPGEN   3392
#define XCD_BAR_WORDS 3456
#define XB_SPIN_CAP (1u << 18)

__device__ __forceinline__ unsigned xb_ld(unsigned* p)              { return __hip_atomic_load(p, __ATOMIC_RELAXED, __HIP_MEMORY_SCOPE_AGENT); }
__device__ __forceinline__ unsigned xb_add(unsigned* p, unsigned v) { return __hip_atomic_fetch_add(p, v, __ATOMIC_RELAXED, __HIP_MEMORY_SCOPE_AGENT); }
__device__ __forceinline__ unsigned xb_xcc_id() { return (unsigned)__builtin_amdgcn_s_getreg((3 << 11) | 20) & 0xFu; }
#define XB_SPIN(cond, bar) do { unsigned _sp = 0; while (cond) { __builtin_amdgcn_s_sleep(1); \
    if ((++_sp & 255u) == 0u) { if (xb_ld(&(bar)[XB_TMO])) break; if (_sp > XB_SPIN_CAP) { atomicAdd(&(bar)[XB_TMO], 1u); break; } } } } while (0)

struct XcdBarrier {
    unsigned* bar; unsigned x;
    volatile LAS unsigned* st;
};

__device__ __forceinline__ XcdBarrier xcd_barrier_post(unsigned* bar, volatile LAS unsigned* st) {
    XcdBarrier b; b.bar = bar; b.x = xb_xcc_id(); b.st = st;
    if (threadIdx.x == 0) (void)xb_add(&bar[XB_XCNT(b.x)], 1u);
    return b;
}
__device__ __forceinline__ void xcd_barrier_complete(unsigned* bar, unsigned x, unsigned& nloc, unsigned& nx) {
    const unsigned G = gridDim.x * gridDim.y * gridDim.z;
    unsigned sum, cnt, mine, sp = 0u;
    for (;;) {
        sum = 0u; cnt = 0u; mine = 0u;
#pragma unroll
        for (unsigned j = 0; j < 16; ++j) { const unsigned c = xb_ld(&bar[XB_XCNT(j)]); sum += c; cnt += (c > 0u) ? 1u : 0u; mine = (j == x) ? c : mine; }
        if (sum == G) break;
        __builtin_amdgcn_s_sleep(1);
        if ((++sp & 255u) == 0u) { if (xb_ld(&bar[XB_TMO])) break; if (sp > XB_SPIN_CAP) { atomicAdd(&bar[XB_TMO], 1u); break; } }
    }
    nloc = mine > 0u ? mine : 1u; nx = cnt > 0u ? cnt : 1u;
}

__device__ __forceinline__ void xcd_barrier(const XcdBarrier& b) {
    asm volatile("s_waitcnt vmcnt(0)" ::: "memory");
    __syncthreads();
    if (threadIdx.x == 0) {
        unsigned* bar = b.bar;
        __builtin_amdgcn_s_waitcnt(0);
        unsigned nloc = b.st[0], nx = b.st[1];
        if (nloc == 0u) { xcd_barrier_complete(bar, b.x, nloc, nx); b.st[0] = nloc; b.st[1] = nx; }
        const unsigned old = xb_add(&bar[XB_XSUB(b.x)], 1u);
        const unsigned gen = old / nloc;
        if (old + 1u == (gen + 1u) * nloc) {
            __builtin_amdgcn_fence(__ATOMIC_RELEASE, "agent");
            asm volatile("s_waitcnt vmcnt(0)" ::: "memory");
            const unsigned og = xb_add(&bar[XB_TOP], 1u);
            const unsigned tg = og / nx;
            if (og + 1u == (tg + 1u) * nx) xb_add(&bar[XB_TOPGEN], 1u);
            else XB_SPIN(xb_ld(&bar[XB_TOPGEN]) == tg, bar);
            __builtin_amdgcn_fence(__ATOMIC_ACQUIRE, "agent");
            xb_add(&bar[XB_XGEN(b.x)], 1u);
            asm volatile("s_waitcnt vmcnt(0)" ::: "memory");
        } else {
            XB_SPIN(xb_ld(&bar[XB_XGEN(b.x)]) == gen, bar);
            __builtin_amdgcn_fence(__ATOMIC_ACQUIRE, "agent");
            asm volatile("s_waitcnt vmcnt(0)" ::: "memory");
        }
    }
    __syncthreads();
}
__device__ __forceinline__ int cond_of_panel(int pm) { return pm < 16 ? 0 : 1 + ((pm - 16) >> 2); }
__device__ __forceinline__ f32x4 relu2(f32x4 v) { f32x4 r; r.x = fmaxf(v.x, 0.f); r.y = fmaxf(v.y, 0.f); r.z = fmaxf(v.z, 0.f); r.w = fmaxf(v.w, 0.f); return r * r; }
__device__ __forceinline__ float silu1(float x) { return x * __builtin_amdgcn_rcpf(1.f + __builtin_amdgcn_exp2f(-1.4426950408889634f * x)); }
__device__ __forceinline__ f32x4 silu4(f32x4 v) { f32x4 r; r.x = silu1(v.x); r.y = silu1(v.y); r.z = silu1(v.z); r.w = silu1(v.w); return r; }
__device__ __forceinline__ v4u pack8(f32x4 a, f32x4 b) { v4u w; w.x = cvtpk(a.x, a.y); w.y = cvtpk(a.z, a.w); w.z = cvtpk(b.x, b.y); w.w = cvtpk(b.z, b.w); return w; }
__device__ __forceinline__ f32x4 rope2(f32x4 v, f32x4 cs) { f32x4 r; r.x = v.x * cs.x - v.y * cs.y; r.y = v.y * cs.x + v.x * cs.y; r.z = v.z * cs.z - v.w * cs.w; r.w = v.w * cs.z + v.z * cs.w; return r; }

struct EpiQKV {
    static constexpr bool PERM = true, AFTER_DRAIN = false;
    const float* rowsq; const float* bias; const float* qnp; const float* taba;
    bf16* Q; bf16* KC; bf16* VC; bf16* KL; bf16* VL; float* nck; float* ncv; LAS float* xch;
    __device__ __forceinline__ void operator()(f32x4 (&acc)[2][2][4][2], const pg8::Unit& u, int wr, int wc, int fr, int fq, int ui) const {
        const int pm = u.pm, pn = u.pn; const bool lat = pm >= 16; const int ci = cond_of_panel(pm);
        const int rl0 = wr * 64 + fr, cw = wc * 32 + 8 * fq;
        {
            f32x4 bv[2][2];
#pragma unroll
            for (int bj = 0; bj < 2; ++bj)
#pragma unroll
                for (int n = 0; n < 2; ++n) bv[bj][n] = *(const f32x4*)(bias + ci * NQKV + pn * 256 + bj * 128 + cw + 4 * n);
#pragma unroll
            for (int ai = 0; ai < 2; ++ai)
#pragma unroll
                for (int m = 0; m < 4; ++m) { const float rs = rsqrtf(rowsq[pm * 256 + rl0 + 128 * ai + 16 * m] * (1.f / DM) + EPS);
#pragma unroll
                    for (int bj = 0; bj < 2; ++bj)
#pragma unroll
                        for (int n = 0; n < 2; ++n) acc[ai][bj][m][n] = acc[ai][bj][m][n] * rs + bv[bj][n]; }
        }
        if (pn < 5) {
            LAS float* X = xch + (ui & 1) * 2048;
#pragma unroll
            for (int ai = 0; ai < 2; ++ai)
#pragma unroll
                for (int m = 0; m < 4; ++m)
#pragma unroll
                    for (int bj = 0; bj < 2; ++bj) { const f32x4 a = acc[ai][bj][m][0], b = acc[ai][bj][m][1];
                        float ss = (a.x * a.x + a.y * a.y) + (a.z * a.z + a.w * a.w) + (b.x * b.x + b.y * b.y) + (b.z * b.z + b.w * b.w);
                        ss += __shfl_xor(ss, 16); ss += __shfl_xor(ss, 32);
                        if (fq == 0) X[(rl0 + 128 * ai + 16 * m) * 8 + bj * 4 + wc] = ss; }
            LDS_WAIT(); __builtin_amdgcn_s_barrier(); asm volatile("" ::: "memory");
            const float* nw = qnp + (pn == 4 ? 128 : 0);
            const f32x4 w0 = *(const f32x4*)(nw + cw), w1 = *(const f32x4*)(nw + cw + 4);
#pragma unroll
            for (int ai = 0; ai < 2; ++ai)
#pragma unroll
                for (int m = 0; m < 4; ++m) {
                    const int rl = rl0 + 128 * ai + 16 * m, row = pm * 256 + rl;
                    f32x4 cs0 = {1.f, 0.f, 1.f, 0.f}, cs1 = {1.f, 0.f, 1.f, 0.f}; int pos = 0, lb = 0;
                    if (lat) { pos = (row - M_CTX) & (S_LAT - 1); lb = (row - M_CTX) >> 10; const float* t = taba + ((size_t)pos * 64 + (cw >> 1)) * 2; cs0 = *(const f32x4*)t; cs1 = *(const f32x4*)(t + 4); }
#pragma unroll
                    for (int bj = 0; bj < 2; ++bj) {
                        const f32x4 p = *(const LAS f32x4*)(X + rl * 8 + bj * 4);
                        const float rn = rsqrtf(((p.x + p.y) + (p.z + p.w)) * (1.f / 128.f) + EPS);
                        f32x4 v0 = acc[ai][bj][m][0] * rn * w0, v1 = acc[ai][bj][m][1] * rn * w1;
                        if (lat) { v0 = rope2(v0, cs0); v1 = rope2(v1, cs1); }
                        const v4u w = pack8(v0, v1);
                        if (pn < 4) *(v4u*)(Q + (size_t)row * DM + pn * 256 + bj * 128 + cw) = w;
                        else if (!lat) {
                            *(v4u*)(KC + (size_t)row * 256 + bj * 128 + cw) = w;
                            const int q0 = cw >> 1, d0 = (q0 >> 5) * 64 + (q0 & 31);
                            float* o = nck + (size_t)row * 256 + bj * 128 + d0;
                            *(f32x4*)o = (f32x4){v0.x, v0.z, v1.x, v1.z}; *(f32x4*)(o + 32) = (f32x4){v0.y, v0.w, v1.y, v1.w};
                        } else *(v4u*)(KL + ((size_t)lb * KVL + PAST + pos) * 256 + bj * 128 + cw) = w;
                    }
                }
        } else {
#pragma unroll
            for (int ai = 0; ai < 2; ++ai)
#pragma unroll
                for (int m = 0; m < 4; ++m) {
                    const int row = pm * 256 + rl0 + 128 * ai + 16 * m;
#pragma unroll
                    for (int bj = 0; bj < 2; ++bj) {
                        const f32x4 v0 = acc[ai][bj][m][0], v1 = acc[ai][bj][m][1]; const v4u w = pack8(v0, v1);
                        if (!lat) { *(v4u*)(VC + (size_t)row * 256 + bj * 128 + cw) = w; float* o = ncv + (size_t)row * 256 + bj * 128 + cw; *(f32x4*)o = v0; *(f32x4*)(o + 4) = v1; }
                        else { const int pos = (row - M_CTX) & (S_LAT - 1), lb = (row - M_CTX) >> 10; *(v4u*)(VL + ((size_t)lb * KVL + PAST + pos) * 256 + bj * 128 + cw) = w; }
                    }
                }
        }
    }
};

struct EpiRes {
    static constexpr bool PERM = true, AFTER_DRAIN = false;
    const float* xin_c; const float* xin_l;
    float* xr; bf16* aout; const float* gate; const float* gs; float* rsq;
    __device__ __forceinline__ void operator()(f32x4 (&acc)[2][2][4][2], const pg8::Unit& u, int wr, int wc, int fr, int fq, int ui) const {
        const int pm = u.pm, pn = u.pn; const int ci = cond_of_panel(pm);
        const int rl0 = wr * 64 + fr, col0 = pn * 256 + wc * 32 + 8 * fq;
        f32x4 gv[2][2], sv[2][2];
#pragma unroll
        for (int bj = 0; bj < 2; ++bj)
#pragma unroll
            for (int n = 0; n < 2; ++n) { gv[bj][n] = *(const f32x4*)(gate + ci * 6144 + col0 + bj * 128 + 4 * n);
                sv[bj][n] = aout ? *(const f32x4*)(gs + ci * DM + col0 + bj * 128 + 4 * n) : (f32x4){0.f, 0.f, 0.f, 0.f}; }
#pragma unroll
        for (int ai = 0; ai < 2; ++ai)
#pragma unroll
            for (int m = 0; m < 4; ++m) {
                const int row = pm * 256 + rl0 + 128 * ai + 16 * m;
                const float* xi = (row < M_CTX ? xin_c + (size_t)row * DM : xin_l + (size_t)(row - M_CTX) * DM) + col0;
                float ss = 0.f;
#pragma unroll
                for (int bj = 0; bj < 2; ++bj) {
                    const f32x4 x0 = *(const f32x4*)(xi + bj * 128), x1 = *(const f32x4*)(xi + bj * 128 + 4);
                    const f32x4 y0 = x0 + gv[bj][0] * acc[ai][bj][m][0], y1 = x1 + gv[bj][1] * acc[ai][bj][m][1];
                    float* o = xr + (size_t)row * DM + col0 + bj * 128; *(f32x4*)o = y0; *(f32x4*)(o + 4) = y1;
                    ss += (y0.x * y0.x + y0.y * y0.y) + (y0.z * y0.z + y0.w * y0.w) + (y1.x * y1.x + y1.y * y1.y) + (y1.z * y1.z + y1.w * y1.w);
                    if (aout) *(v4u*)(aout + (size_t)row * DM + col0 + bj * 128) = pack8(y0 * sv[bj][0], y1 * sv[bj][1]);
                }
                ss += __shfl_xor(ss, 16); ss += __shfl_xor(ss, 32);
                if (fq == 0) atomicAdd(rsq + row, ss);
            }
    }
};

struct EpiMlp1 {
    static constexpr bool PERM = true, AFTER_DRAIN = false;
    const float* rowsq; const float* bias; bf16* H;
    __device__ __forceinline__ void operator()(f32x4 (&acc)[2][2][4][2], const pg8::Unit& u, int wr, int wc, int fr, int fq, int ui) const {
        const int pm = u.pm, pn = u.pn; const int ci = cond_of_panel(pm);
        const int rl0 = wr * 64 + fr, col0 = pn * 256 + wc * 32 + 8 * fq;
        f32x4 bv[2][2];
#pragma unroll
        for (int bj = 0; bj < 2; ++bj)
#pragma unroll
            for (int n = 0; n < 2; ++n) bv[bj][n] = *(const f32x4*)(bias + ci * FFD + col0 + bj * 128 + 4 * n);
#pragma unroll
        for (int ai = 0; ai < 2; ++ai)
#pragma unroll
            for (int m = 0; m < 4; ++m) {
                const int row = pm * 256 + rl0 + 128 * ai + 16 * m; const float rs = rsqrtf(rowsq[row] * (1.f / DM) + EPS);
#pragma unroll
                for (int bj = 0; bj < 2; ++bj)
                    *(v4u*)(H + (size_t)row * FFD + col0 + bj * 128) = pack8(relu2(acc[ai][bj][m][0] * rs + bv[bj][0]), relu2(acc[ai][bj][m][1] * rs + bv[bj][1]));
            }
    }
};

struct EpiProj {
    static constexpr bool PERM = true, AFTER_DRAIN = false;
    const float* rowsq; const float* bias; const float* tabr; bf16* RQ; bf16* RK; bf16* RV; bf16* RG;
    __device__ __forceinline__ void operator()(f32x4 (&acc)[2][2][4][2], const pg8::Unit& u, int wr, int wc, int fr, int fq, int ui) const {
        const int pm = u.pm, pn = u.pn; const bool lat = pm >= 16; const int ci = cond_of_panel(pm);
        const int rl0 = wr * 64 + fr, cw = wc * 32 + 8 * fq;
        f32x4 bv[2][2];
#pragma unroll
        for (int bj = 0; bj < 2; ++bj)
#pragma unroll
            for (int n = 0; n < 2; ++n) bv[bj][n] = *(const f32x4*)(bias + ci * NRETP + pn * 256 + bj * 128 + cw + 4 * n);
        bf16* dst = RQ + (size_t)(pn >> 2) * ((size_t)MTOK * DM) + (pn & 3) * 256 + cw;
        const float qs = pn < 4 ? 0.0625f : 1.f;
#pragma unroll
        for (int ai = 0; ai < 2; ++ai)
#pragma unroll
            for (int m = 0; m < 4; ++m) {
                const int row = pm * 256 + rl0 + 128 * ai + 16 * m; const float rs = rsqrtf(rowsq[row] * (1.f / DM) + EPS);
                const int pos = (row - M_CTX) & (S_LAT - 1);
#pragma unroll
                for (int bj = 0; bj < 2; ++bj) {
                    f32x4 v0 = acc[ai][bj][m][0] * rs + bv[bj][0], v1 = acc[ai][bj][m][1] * rs + bv[bj][1];
                    if (pn < 8) {
                        if (lat) { const float* t = tabr + ((size_t)pos * 128 + 64 * bj + (cw >> 1)) * 2; v0 = rope2(v0, *(const f32x4*)t); v1 = rope2(v1, *(const f32x4*)(t + 4)); }
                        v0 = v0 * qs; v1 = v1 * qs;
                    } else if (pn >= 12) { v0 = silu4(v0); v1 = silu4(v1); }
                    *(v4u*)(dst + (size_t)row * DM + bj * 128) = pack8(v0, v1);
                }
            }
    }
};
__device__ __forceinline__ float wave_sum(float v) {
#pragma unroll
    for (int o = 1; o < 64; o <<= 1) v += __shfl_xor(v, o);
    return v;
}
template <int MAP> __device__ __forceinline__ int rowmap(int n) {
    if (MAP == 1) return n < 1280 ? (n & ~127) + posA(n & 127) : n;
    if (MAP == 2) return n < 2048 ? (n & ~255) + posR(n & 255) : n;
    return n;
}
template <int MAP> __device__ __forceinline__ void p0_transpose_item(const float* W, int K, int N, bf16* WT, LAS float* scr, int item, int lane) {
    const int nblk = N / 32, kb = item / nblk, nb = item % nblk, k0 = 64 * kb, n0 = 32 * nb;
#pragma unroll 8
    for (int i = 0; i < 32; ++i) { const int kk = 2 * i + (lane >> 5); scr[kk * 33 + (lane & 31)] = W[(size_t)(k0 + kk) * N + n0 + (lane & 31)]; }
    LDS_WAIT(); asm volatile("" ::: "memory");
    const int c = lane & 7;
#pragma unroll
    for (int j = 0; j < 4; ++j) { const int n = (lane >> 3) + 8 * j; const LAS float* s = scr + (8 * c) * 33 + n;
        v4u o; o.x = pk2(s[0 * 33], s[1 * 33]); o.y = pk2(s[2 * 33], s[3 * 33]); o.z = pk2(s[4 * 33], s[5 * 33]); o.w = pk2(s[6 * 33], s[7 * 33]);
        *(GAS v4u*)(WT + (size_t)rowmap<MAP>(n0 + n) * K + k0 + 8 * c) = o; }
    LDS_WAIT(); asm volatile("" ::: "memory");
}
template <int MAP, int VEC> __device__ __forceinline__ void p0_gemv_item(const float* W, int N, int n0, int k0, const float* vsrc, int vstride, const float* c_ctx, const float* c_lat,
                                                                         float* out, int ostride, const float* addb, LAS float* scr, int lane) {
#pragma unroll
    for (int ci = 0; ci < NCOND; ++ci) {
        float v;
        if (VEC == 0) { const float x = (ci == 0 ? c_ctx : c_lat + (ci - 1) * DM)[k0 + lane]; v = x / (1.f + expf(-x)); }
        else v = vsrc[(size_t)ci * vstride + k0 + lane];
        scr[ci * 64 + lane] = v;
    }
    LDS_WAIT(); asm volatile("" ::: "memory");
    f32x4 a[NCOND];
#pragma unroll
    for (int ci = 0; ci < NCOND; ++ci) a[ci] = (f32x4){0.f, 0.f, 0.f, 0.f};
    const float* wp = W + (size_t)k0 * N + n0 + 4 * lane;
#pragma unroll 1
    for (int kk = 0; kk < 64; kk += 4) {
        f32x4 w[4];
#pragma unroll
        for (int j = 0; j < 4; ++j) w[j] = *(const f32x4*)(wp + (size_t)(kk + j) * N);
#pragma unroll
        for (int ci = 0; ci < NCOND; ++ci) { const f32x4 s = *(const LAS f32x4*)(scr + ci * 64 + kk);
            a[ci] = a[ci] + w[0] * s.x + w[1] * s.y + w[2] * s.z + w[3] * s.w; }
    }
    const int n = n0 + 4 * lane;
#pragma unroll
    for (int ci = 0; ci < NCOND; ++ci) {
        f32x4 r = a[ci];
        if (addb && k0 == 0) r = r + *(const f32x4*)(addb + n);
        float* o = out + (size_t)ci * ostride;
        atomicAdd(o + rowmap<MAP>(n), r.x); atomicAdd(o + rowmap<MAP>(n + 1), r.y); atomicAdd(o + rowmap<MAP>(n + 2), r.z); atomicAdd(o + rowmap<MAP>(n + 3), r.w);
    }
    LDS_WAIT(); asm volatile("" ::: "memory");
}
namespace att {
constexpr int D = 128, NW = 8, QBLK = 32, KVBLK = 64;
constexpr float SCALE = 0.088388347648318440f;
constexpr float THR = 8.f;
constexpr int LDQ = 1024, LDK = 256, LDO = 1024;
constexpr size_t SHM_V = KVBLK * D * 2, SHM_K = KVBLK * D * 2, SHM_ATTN = 2 * SHM_V + 2 * SHM_K + NW * 64 * 4;
#define KSWZ(row, colB) ((row) * 256 + ((colB) ^ (((row) & 7) << 4)))
#define SBAR() __builtin_amdgcn_sched_barrier(0)
__device__ __forceinline__ int crow(int r, int hi) { return (r & 3) + 8 * (r >> 2) + 4 * hi; }
__device__ __forceinline__ void partialSM(f32x16& p0, f32x16& p1, float& m_reg, float& mn, float& alpha) {
  constexpr float C = SCALE * 1.4426950408889634f;
  float pmax = p0[0]; for (int r = 1; r < 16; ++r) pmax = fmaxf(pmax, p0[r]); for (int r = 0; r < 16; ++r) pmax = fmaxf(pmax, p1[r]);
  { auto rr = __builtin_amdgcn_permlane32_swap(__float_as_uint(pmax), __float_as_uint(pmax), false, false);
    pmax = fmaxf(__uint_as_float(rr[0]), __uint_as_float(rr[1])); }
  if (__builtin_expect(__all(pmax - m_reg <= THR / SCALE), 1)) { mn = m_reg; alpha = 1.f; }
  else { mn = fmaxf(m_reg, pmax); alpha = __builtin_amdgcn_exp2f((m_reg - mn) * C); m_reg = mn; }
  float mnC = -mn * C;
  for (int r = 0; r < 16; ++r) p0[r] = fmaf(p0[r], C, mnC); for (int r = 0; r < 16; ++r) p1[r] = fmaf(p1[r], C, mnC);
  for (int r = 0; r < 16; ++r) p0[r] = __builtin_amdgcn_exp2f(p0[r]);
}
__device__ __forceinline__ void finishSM(f32x16& p0, f32x16& p1, float alpha, float& l_reg, bf16x8& pa0, bf16x8& pa1, bf16x8& pa2, bf16x8& pa3) {
  for (int r = 0; r < 16; ++r) p1[r] = __builtin_amdgcn_exp2f(p1[r]);
  float ps = 0; for (int r = 0; r < 16; ++r) ps += p0[r]; for (int r = 0; r < 16; ++r) ps += p1[r];
  { auto rr = __builtin_amdgcn_permlane32_swap(__float_as_uint(ps), __float_as_uint(ps), false, false);
    ps = __uint_as_float(rr[0]) + __uint_as_float(rr[1]); }
  l_reg = l_reg * alpha + ps;
#define PK4(P, BASE, OUT) do { unsigned a0 = cvtpk(P[BASE + 0], P[BASE + 1]), a1 = cvtpk(P[BASE + 2], P[BASE + 3]);   \
    unsigned b0 = cvtpk(P[BASE + 4], P[BASE + 5]), b1 = cvtpk(P[BASE + 6], P[BASE + 7]);                              \
    auto r0 = __builtin_amdgcn_permlane32_swap(a0, b0, false, false); auto r1 = __builtin_amdgcn_permlane32_swap(a1, b1, false, false); \
    v4u w = {r0[0], r1[0], r0[1], r1[1]}; OUT = *reinterpret_cast<bf16x8*>(&w); } while (0)
  PK4(p0, 0, pa0); PK4(p0, 8, pa1); PK4(p1, 0, pa2); PK4(p1, 8, pa3);
#undef PK4
}
__device__ __forceinline__ void qkt(f32x16& p0, f32x16& p1, const bf16* Ks, const bf16x8* qr, int r32, int hi) {
  p0 = f32x16{}; p1 = f32x16{};
  for (int d0 = 0; d0 < 8; ++d0) { int cb = (d0 * 16 + hi * 8) * 2;
    bf16x8 b0 = *reinterpret_cast<const bf16x8*>((const char*)Ks + KSWZ(r32, cb));
    bf16x8 b1 = *reinterpret_cast<const bf16x8*>((const char*)Ks + KSWZ(32 + r32, cb));
    p0 = __builtin_amdgcn_mfma_f32_32x32x16_bf16(b0, qr[d0], p0, 0, 0, 0);
    p1 = __builtin_amdgcn_mfma_f32_32x32x16_bf16(b1, qr[d0], p1, 0, 0, 0); }
}
__device__ __forceinline__ int v_st(int k, int c) { const int kk = (k & ~0xC) | ((k & 4) << 1) | ((k & 8) >> 1); return ((kk >> 3) * 4 + (c >> 5)) * 512 + ((kk & 7) * 32 + (c & 31)) * 2; }
__device__ __forceinline__ int v_rd_base(int lane) { return ((lane & 3) << 3) | (((lane >> 2) & 3) << 6) | (((lane >> 4) & 1) << 5) | (((lane >> 5) & 1) << 8); }
constexpr int v_rd_off(int d0, int ks, int half) { return d0 * 512 + ks * 4096 + half * 2048; }
template <int OFF> __device__ __forceinline__ s16x4 tr_read(int vb) {
  s16x4 r; asm volatile("ds_read_b64_tr_b16 %0, %1 offset:%2" : "=&v"(r) : "v"(vb), "i"(OFF) : "memory"); return r;
}
#define ATT_PK(L, H) (bf16x8){L[0], L[1], L[2], L[3], H[0], H[1], H[2], H[3]}
template <int D0> __device__ __forceinline__ void pv_one(f32x16& od, int vb, bf16x8 pa0, bf16x8 pa1, bf16x8 pa2, bf16x8 pa3) {
  const s16x4 l0 = tr_read<v_rd_off(D0, 0, 0)>(vb), h0 = tr_read<v_rd_off(D0, 0, 1)>(vb), l1 = tr_read<v_rd_off(D0, 1, 0)>(vb), h1 = tr_read<v_rd_off(D0, 1, 1)>(vb);
  const s16x4 l2 = tr_read<v_rd_off(D0, 2, 0)>(vb), h2 = tr_read<v_rd_off(D0, 2, 1)>(vb), l3 = tr_read<v_rd_off(D0, 3, 0)>(vb), h3 = tr_read<v_rd_off(D0, 3, 1)>(vb);
  asm volatile("s_waitcnt lgkmcnt(0)" ::: "memory"); SBAR();
  od = __builtin_amdgcn_mfma_f32_32x32x16_bf16(pa0, ATT_PK(l0, h0), od, 0, 0, 0);
  od = __builtin_amdgcn_mfma_f32_32x32x16_bf16(pa1, ATT_PK(l1, h1), od, 0, 0, 0);
  od = __builtin_amdgcn_mfma_f32_32x32x16_bf16(pa2, ATT_PK(l2, h2), od, 0, 0, 0);
  od = __builtin_amdgcn_mfma_f32_32x32x16_bf16(pa3, ATT_PK(l3, h3), od, 0, 0, 0);
}
__device__ __forceinline__ void pv_d0(f32x16* o, int vb, bf16x8 pa0, bf16x8 pa1, bf16x8 pa2, bf16x8 pa3) {
  pv_one<0>(o[0], vb, pa0, pa1, pa2, pa3); pv_one<1>(o[1], vb, pa0, pa1, pa2, pa3); pv_one<2>(o[2], vb, pa0, pa1, pa2, pa3); pv_one<3>(o[3], vb, pa0, pa1, pa2, pa3);
}
__device__ __forceinline__ void attn_unit(const bf16* Qb, const bf16* __restrict__ Kh, const bf16* __restrict__ Vh, bf16* Ob, int seq, char* lds) {
  const int tid = threadIdx.x, wid = tid >> 6, lane = tid & 63, r32 = lane & 31, hi = lane >> 5;
  bf16* V_lds = (bf16*)lds; bf16* K_lds = (bf16*)(lds + 2 * SHM_V);
  float* ws = (float*)(lds + 2 * SHM_V + 2 * SHM_K) + wid * 64; float* li_l = ws; float* al_l = ws + 32;
  float m_reg = -1e30f, l_reg = 0; f32x16 o[4] = {}; bf16x8 qr[8];
  const bf16* Qw = Qb + (long)(wid * QBLK + r32) * LDQ + hi * 8;
#pragma unroll
  for (int d0 = 0; d0 < 8; ++d0) qr[d0] = *reinterpret_cast<const bf16x8*>(Qw + d0 * 16);
  const int sr = tid >> 4, sc = (tid & 15) * 8, vst0 = v_st(sr, sc), vst1 = v_st(32 + sr, sc);
  const int vb0 = (int)(uintptr_t)V_lds + v_rd_base(lane);
  struct { bf16x8 vs0, vs1, ks0, ks1; } sr_[2];
#define SLOAD(i, k0) do { sr_[i].vs0 = *reinterpret_cast<const bf16x8*>(&Vh[(long)((k0) + sr) * LDK + sc]); sr_[i].vs1 = *reinterpret_cast<const bf16x8*>(&Vh[(long)((k0) + 32 + sr) * LDK + sc]); \
    sr_[i].ks0 = *reinterpret_cast<const bf16x8*>(&Kh[(long)((k0) + sr) * LDK + sc]); sr_[i].ks1 = *reinterpret_cast<const bf16x8*>(&Kh[(long)((k0) + 32 + sr) * LDK + sc]); } while (0)
#define SWRITE(b, i) do { *(bf16x8*)((char*)V_lds + (b) * SHM_V + vst0) = sr_[i].vs0;          \
    *(bf16x8*)((char*)V_lds + (b) * SHM_V + vst1) = sr_[i].vs1; int kc = sc * 2;               \
    *(bf16x8*)((char*)K_lds + (b) * SHM_K + KSWZ(sr, kc)) = sr_[i].ks0;                       \
    *(bf16x8*)((char*)K_lds + (b) * SHM_K + KSWZ(32 + sr, kc)) = sr_[i].ks1; } while (0)
#define SWAIT() asm volatile("s_waitcnt vmcnt(4)" ::: "memory")
#define RESC(a) do { if (__any((a) < 1.f)) { if (hi == 0) al_l[r32] = (a); asm volatile("s_waitcnt lgkmcnt(0)" ::: "memory"); \
    for (int d = 0; d < 4; ++d) for (int r = 0; r < 16; ++r) o[d][r] *= al_l[crow(r, hi)]; } } while (0)
  f32x16 pA0, pA1, pB0, pB1; float mnA, mnB, alA, alB; bf16x8 pa0, pa1, pa2, pa3; const int NT = seq / KVBLK;
  constexpr int SE = 0, SO = 1;
  SLOAD(SE, 0); asm volatile("s_waitcnt vmcnt(0)" ::: "memory"); SWRITE(0, SE); __syncthreads();
  qkt(pA0, pA1, K_lds, qr, r32, hi); partialSM(pA0, pA1, m_reg, mnA, alA);
  SLOAD(SO, KVBLK); if (2 < NT) SLOAD(SE, 2 * KVBLK);
  SWAIT(); SWRITE(1, SO); __syncthreads();
  for (int j = 1; j + 1 < NT; j += 2) {
    SBAR(); qkt(pB0, pB1, (bf16*)((char*)K_lds + SHM_K), qr, r32, hi);
    finishSM(pA0, pA1, alA, l_reg, pa0, pa1, pa2, pa3); SBAR();
    SLOAD(SO, (j + 2) * KVBLK); SBAR();
    pv_d0(o, vb0, pa0, pa1, pa2, pa3); partialSM(pB0, pB1, m_reg, mnB, alB);
    __syncthreads(); SWAIT(); SWRITE(0, SE);
    RESC(alB); __syncthreads();
    SBAR(); qkt(pA0, pA1, K_lds, qr, r32, hi);
    finishSM(pB0, pB1, alB, l_reg, pa0, pa1, pa2, pa3); SBAR();
    if (j + 3 < NT) SLOAD(SE, (j + 3) * KVBLK); SBAR();
    pv_d0(o, vb0 + (int)SHM_V, pa0, pa1, pa2, pa3); partialSM(pA0, pA1, m_reg, mnA, alA);
    __syncthreads(); SWAIT(); SWRITE(1, SO);
    RESC(alA); __syncthreads();
  }
  SBAR(); qkt(pB0, pB1, (bf16*)((char*)K_lds + SHM_K), qr, r32, hi);
  finishSM(pA0, pA1, alA, l_reg, pa0, pa1, pa2, pa3); SBAR();
  pv_d0(o, vb0, pa0, pa1, pa2, pa3); partialSM(pB0, pB1, m_reg, mnB, alB);
  __syncthreads(); RESC(alB);
  finishSM(pB0, pB1, alB, l_reg, pa0, pa1, pa2, pa3); SBAR();
  pv_d0(o, vb0 + (int)SHM_V, pa0, pa1, pa2, pa3);
  if (hi == 0) li_l[r32] = l_reg; asm volatile("s_waitcnt lgkmcnt(0)" ::: "memory");
  float rli[16];
#pragma unroll
  for (int r = 0; r < 16; ++r) rli[r] = __builtin_amdgcn_rcpf(li_l[crow(r, hi)]);
  __syncthreads();
  { unsigned short* stg = (unsigned short*)(lds + wid * 8192);
#pragma unroll
    for (int r = 0; r < 16; ++r) { const int orow = crow(r, hi);
#pragma unroll
      for (int d0 = 0; d0 < 4; ++d0) stg[orow * 128 + d0 * 32 + r32] = (unsigned short)f2bf(o[d0][r] * rli[r]); }
    asm volatile("s_waitcnt lgkmcnt(0)" ::: "memory");
    bf16* Ow = Ob + (long)(wid * QBLK) * LDO;
#pragma unroll
    for (int i = 0; i < 8; ++i) { const int row = i * 4 + (lane >> 4), ch = lane & 15; const v4u v = *(const v4u*)(stg + row * 128 + ch * 8); *(v4u*)(Ow + (long)row * LDO + ch * 8) = v; } }
  __syncthreads();
#undef SLOAD
#undef SWRITE
#undef SWAIT
#undef RESC
}
#undef KSWZ
#undef SBAR
}
namespace ret {
using att::v_st; using att::v_rd_base; using att::v_rd_off; using att::tr_read; using att::crow;
#define SBAR() __builtin_amdgcn_sched_barrier(0)
#define RET_PK(L, H) (bf16x8){L[0], L[1], L[2], L[3], H[0], H[1], H[2], H[3]}
__device__ __forceinline__ float log_sigmoid(float x) { return fminf(x, 0.f) - log1pf(expf(-fabsf(x))); }
__device__ __forceinline__ bf16x8 scale8(bf16x8 v, float s) {
    const v4u u = __builtin_bit_cast(v4u, v); v4u r;
    r.x = cvtpk(__builtin_bit_cast(float, u.x << 16) * s, __builtin_bit_cast(float, u.x & 0xffff0000u) * s);
    r.y = cvtpk(__builtin_bit_cast(float, u.y << 16) * s, __builtin_bit_cast(float, u.y & 0xffff0000u) * s);
    r.z = cvtpk(__builtin_bit_cast(float, u.z << 16) * s, __builtin_bit_cast(float, u.z & 0xffff0000u) * s);
    r.w = cvtpk(__builtin_bit_cast(float, u.w << 16) * s, __builtin_bit_cast(float, u.w & 0xffff0000u) * s);
    return __builtin_bit_cast(bf16x8, r);
}
constexpr int CH = 128;
constexpr int A_BUF = 49152;

template <int KS> __device__ __forceinline__ void retA_ks(f32x16 (&acc)[2][2], int kb, int vb) {
    const s16x4 a0l = tr_read<v_rd_off(0, KS, 0)>(kb), a0h = tr_read<v_rd_off(0, KS, 1)>(kb), a1l = tr_read<v_rd_off(1, KS, 0)>(kb), a1h = tr_read<v_rd_off(1, KS, 1)>(kb);
    const s16x4 b0l = tr_read<v_rd_off(0, KS, 0)>(vb), b0h = tr_read<v_rd_off(0, KS, 1)>(vb), b1l = tr_read<v_rd_off(1, KS, 0)>(vb), b1h = tr_read<v_rd_off(1, KS, 1)>(vb);
    asm volatile("s_waitcnt lgkmcnt(0)" ::: "memory"); SBAR();
    const bf16x8 a0 = RET_PK(a0l, a0h), a1 = RET_PK(a1l, a1h), b0 = RET_PK(b0l, b0h), b1 = RET_PK(b1l, b1h);
    acc[0][0] = __builtin_amdgcn_mfma_f32_32x32x16_bf16(a0, b0, acc[0][0], 0, 0, 0);
    acc[0][1] = __builtin_amdgcn_mfma_f32_32x32x16_bf16(a0, b1, acc[0][1], 0, 0, 0);
    acc[1][0] = __builtin_amdgcn_mfma_f32_32x32x16_bf16(a1, b0, acc[1][0], 0, 0, 0);
    acc[1][1] = __builtin_amdgcn_mfma_f32_32x32x16_bf16(a1, b1, acc[1][1], 0, 0, 0);
}

struct RetAArgs { const bf16* RK; const bf16* RV; const float* state_in; const float* decay_logit; bf16* STC; bf16* STL; float* state_out; };
__device__ __forceinline__ void retA_unit(const RetAArgs& R, int lat, int b, int h, int dir, int dvh, LAS unsigned char* lds) {
    const int tid = threadIdx.x, wid = tid >> 6, lane = tid & 63, r32 = lane & 31, hi = lane >> 5;
    const int wq = wid >> 1, wd = wid & 1;
    const int nc = lat ? 8 : 2; const long row0 = lat ? M_CTX + (long)b * S_LAT : (long)b * S_CTX;
    const float lg = log_sigmoid(R.decay_logit[dir * 4 + h]); const float cdec = expf(lg * (float)CH);
    f32x16 acc[2][2];
    if (lat) {
        const float* si = R.state_in + ((size_t)((b * 2 + dir) * 4 + h) * 256) * 256 + dvh * 128 + wd * 64 + r32;
#pragma unroll
        for (int ia = 0; ia < 2; ++ia)
#pragma unroll
            for (int r = 0; r < 16; ++r) { const int d = dimR(wq * 64 + ia * 32 + crow(r, hi));
                acc[ia][0][r] = si[(size_t)d * 256]; acc[ia][1][r] = si[(size_t)d * 256 + 32]; }
    } else {
#pragma unroll
        for (int ia = 0; ia < 2; ++ia)
#pragma unroll
            for (int ib = 0; ib < 2; ++ib) acc[ia][ib] = f32x16{};
    }
    const int sr = tid >> 4, sc = (tid & 15) * 8, st0 = v_st(sr, sc), st1 = v_st(32 + sr, sc);
    const int lbase = (int)(uintptr_t)lds;
    const int kb0 = lbase + (wq >> 1) * 16384 + (wq & 1) * 1024 + v_rd_base(lane);
    const int vb0 = lbase + 32768 + wd * 1024 + v_rd_base(lane);
    const bf16* Kg = R.RK + row0 * DM + h * 256 + sc; const bf16* Vg = R.RV + row0 * DM + h * 256 + dvh * 128 + sc;
    bf16x8 k00, k01, k10, k11, v0, v1;
#define RA_LOAD(tok0) do { const bf16* kp = Kg + (long)((tok0) + sr) * DM; const bf16* vp = Vg + (long)((tok0) + sr) * DM; \
        k00 = *(const bf16x8*)kp; k01 = *(const bf16x8*)(kp + 32 * DM); k10 = *(const bf16x8*)(kp + 128); k11 = *(const bf16x8*)(kp + 32 * DM + 128); \
        v0 = *(const bf16x8*)vp; v1 = *(const bf16x8*)(vp + 32 * DM); } while (0)
#define RA_WRITE(buf, jl0) do { LAS unsigned char* B_ = lds + (buf) * A_BUF; \
        const float e0 = dir ? (float)((jl0) + sr) : (float)(CH - 1 - (jl0) - sr), e1 = dir ? e0 + 32.f : e0 - 32.f; \
        *(LAS bf16x8*)(B_ + st0) = k00; *(LAS bf16x8*)(B_ + st1) = k01; *(LAS bf16x8*)(B_ + 16384 + st0) = k10; *(LAS bf16x8*)(B_ + 16384 + st1) = k11; \
        *(LAS bf16x8*)(B_ + 32768 + st0) = scale8(v0, expf(lg * e0)); *(LAS bf16x8*)(B_ + 32768 + st1) = scale8(v1, expf(lg * e1)); } while (0)
    const int nsteps = lat ? nc - 1 : nc;
    const int nsub = nsteps * 2;
    { const int cc = dir ? nc - 1 : 0; RA_LOAD(cc * CH); }
    VM_WAIT(); RA_WRITE(0, 0);
    __syncthreads();
    for (int s = 0; s < nsub; ++s) {
        const int c = s >> 1, half = s & 1, cc = dir ? nc - 1 - c : c;
        if (half == 0) {
            if (lat || c > 0) {
                bf16* st = lat ? R.STL + ((size_t)(((b * 4 + h) * 2 + dir) * 8 + cc) << 16) : R.STC + ((size_t)((b * 4 + h) * 2 + dir) << 16);
#pragma unroll
                for (int ia = 0; ia < 2; ++ia)
#pragma unroll
                    for (int ib = 0; ib < 2; ++ib) { bf16* sp = st + (size_t)(dvh * 128 + wd * 64 + ib * 32 + r32) * 256 + wq * 64 + ia * 32 + 4 * hi;
#pragma unroll
                        for (int g = 0; g < 4; ++g) { v2u w; w.x = cvtpk(acc[ia][ib][4 * g], acc[ia][ib][4 * g + 1]); w.y = cvtpk(acc[ia][ib][4 * g + 2], acc[ia][ib][4 * g + 3]); *(v2u*)(sp + 8 * g) = w; } }
            }
#pragma unroll
            for (int ia = 0; ia < 2; ++ia)
#pragma unroll
                for (int ib = 0; ib < 2; ++ib) acc[ia][ib] = acc[ia][ib] * cdec;
        }
        if (s + 1 < nsub) { const int s1 = s + 1, c1 = s1 >> 1, cc1 = dir ? nc - 1 - c1 : c1; RA_LOAD(cc1 * CH + (s1 & 1) * 64); }
        const int bo = (s & 1) * A_BUF;
        retA_ks<0>(acc, kb0 + bo, vb0 + bo); retA_ks<1>(acc, kb0 + bo, vb0 + bo); retA_ks<2>(acc, kb0 + bo, vb0 + bo); retA_ks<3>(acc, kb0 + bo, vb0 + bo);
        if (s + 1 < nsub) { VM_WAIT(); RA_WRITE((s + 1) & 1, ((s + 1) & 1) * 64); }
        __syncthreads();
    }
    if (lat) {
        const int cc = dir ? 0 : nc - 1;
        bf16* st = R.STL + ((size_t)(((b * 4 + h) * 2 + dir) * 8 + cc) << 16);
#pragma unroll
        for (int ia = 0; ia < 2; ++ia)
#pragma unroll
            for (int ib = 0; ib < 2; ++ib) { bf16* sp = st + (size_t)(dvh * 128 + wd * 64 + ib * 32 + r32) * 256 + wq * 64 + ia * 32 + 4 * hi;
#pragma unroll
                for (int g = 0; g < 4; ++g) { v2u w; w.x = cvtpk(acc[ia][ib][4 * g], acc[ia][ib][4 * g + 1]); w.y = cvtpk(acc[ia][ib][4 * g + 2], acc[ia][ib][4 * g + 3]); *(v2u*)(sp + 8 * g) = w; } }
    } else {
        float* so = R.state_out + ((size_t)((b * 2 + dir) * 4 + h) * 256) * 256 + dvh * 128 + wd * 64 + r32;
#pragma unroll
        for (int ia = 0; ia < 2; ++ia)
#pragma unroll
            for (int r = 0; r < 16; ++r) { const int d = dimR(wq * 64 + ia * 32 + crow(r, hi));
                so[(size_t)d * 256] = acc[ia][0][r]; so[(size_t)d * 256 + 32] = acc[ia][1][r]; }
    }
#undef RA_LOAD
#undef RA_WRITE
}

__device__ __forceinline__ int img_off(int row, int chunk) { return row * 256 + ((chunk ^ (row & 15)) << 4); }
__device__ __forceinline__ void stage_img(LAS unsigned char* img, const bf16* src, int nrows, int ld, int tid) {
    const int tr = tid >> 4, ch = tid & 15;
    for (int r = tr; r < nrows; r += 32) *(LAS bf16x8*)(img + img_off(r, ch)) = *(const bf16x8*)(src + (size_t)r * ld + ch * 8);
}
__device__ __forceinline__ bf16x8 frag(const LAS unsigned char* img, int rb, int ks, int r32, int hi) { return *(const LAS bf16x8*)(img + img_off(rb + r32, 2 * ks + hi)); }

struct RetBArgs { const bf16* RQ; const bf16* RK; const bf16* RV; const bf16* RG; const bf16* STC; const bf16* STL; const float* decay_logit; const float* gn_w; bf16* RO; };
__device__ __forceinline__ void retB_unit(const RetBArgs& R, int lat, int b, int h, int cc, LAS unsigned char* lds) {
    const int tid = threadIdx.x, wid = tid >> 6, lane = tid & 63, r32 = lane & 31, hi = lane >> 5;
    const int wr2 = wid >> 2, wc4 = wid & 3;
    const int nc = lat ? 8 : 2; const long row0 = (lat ? M_CTX + (long)b * S_LAT : (long)b * S_CTX) + cc * CH;
    const float lgf = log_sigmoid(R.decay_logit[h]), lgb = log_sigmoid(R.decay_logit[4 + h]);
    LAS unsigned char* RA = lds; LAS unsigned char* RB = lds + 65536;
    LAS float* rtab = (LAS float*)(lds + XCH_OFF);
    const bool has_f = lat || cc > 0, has_b = lat || cc < nc - 1;
    if (tid < CH) { const float i = (float)tid; const float df = expf(lgf * (i + 1.f)), db = expf(lgb * ((float)CH - i));
        rtab[tid] = has_b ? df / db : 1.f; rtab[CH + tid] = has_b ? db : df; }
    const bf16* Qg = R.RQ + row0 * DM + h * 256; const bf16* Kg = R.RK + row0 * DM + h * 256;
    stage_img(RA, Qg, CH, DM, tid); stage_img(RA + 32768, Qg + 128, CH, DM, tid);
    stage_img(RB, Kg, CH, DM, tid); stage_img(RB + 32768, Kg + 128, CH, DM, tid);
    __syncthreads();
    unsigned pk[2][8];
    {
        f32x16 p0 = f32x16{}, p1 = f32x16{}; const int ibq = wid & 3, jb0 = (wid >> 2) * 2;
#pragma unroll
        for (int ks = 0; ks < 16; ++ks) { const int im = (ks >> 3) * 32768, k8 = ks & 7;
            const bf16x8 qf = frag(RA + im, ibq * 32, k8, r32, hi), kf0 = frag(RB + im, jb0 * 32, k8, r32, hi), kf1 = frag(RB + im, jb0 * 32 + 32, k8, r32, hi);
            p0 = __builtin_amdgcn_mfma_f32_32x32x16_bf16(kf0, qf, p0, 0, 0, 0);
            p1 = __builtin_amdgcn_mfma_f32_32x32x16_bf16(kf1, qf, p1, 0, 0, 0); }
        const int i = ibq * 32 + r32;
#pragma unroll
        for (int r = 0; r < 16; ++r) { const int j0 = jb0 * 32 + crow(r, hi), j1 = j0 + 32;
            p0[r] *= (i >= j0) ? expf(lgf * (float)(i - j0)) : expf(lgb * (float)(j0 - i));
            p1[r] *= (i >= j1) ? expf(lgf * (float)(i - j1)) : expf(lgb * (float)(j1 - i)); }
#pragma unroll
        for (int g = 0; g < 4; ++g) { pk[0][2 * g] = cvtpk(p0[4 * g], p0[4 * g + 1]); pk[0][2 * g + 1] = cvtpk(p0[4 * g + 2], p0[4 * g + 3]);
            pk[1][2 * g] = cvtpk(p1[4 * g], p1[4 * g + 1]); pk[1][2 * g + 1] = cvtpk(p1[4 * g + 2], p1[4 * g + 3]); }
    }
    __syncthreads();
    f32x16 acc[2][2];
#pragma unroll
    for (int ia = 0; ia < 2; ++ia)
#pragma unroll
        for (int ib = 0; ib < 2; ++ib) acc[ia][ib] = f32x16{};
#define RB_STATE(stp) do { _Pragma("unroll 1") for (int kh = 0; kh < 2; ++kh) { \
        stage_img(RB, (stp) + kh * 128, 256, 256, tid); __syncthreads(); \
        _Pragma("unroll") for (int ks = 0; ks < 8; ++ks) { \
            const bf16x8 a0 = frag(RA + kh * 32768, wr2 * 64, ks, r32, hi), a1 = frag(RA + kh * 32768, wr2 * 64 + 32, ks, r32, hi); \
            const bf16x8 b0 = frag(RB, wc4 * 64, ks, r32, hi), b1 = frag(RB, wc4 * 64 + 32, ks, r32, hi); \
            acc[0][0] = __builtin_amdgcn_mfma_f32_32x32x16_bf16(a0, b0, acc[0][0], 0, 0, 0); acc[0][1] = __builtin_amdgcn_mfma_f32_32x32x16_bf16(a0, b1, acc[0][1], 0, 0, 0); \
            acc[1][0] = __builtin_amdgcn_mfma_f32_32x32x16_bf16(a1, b0, acc[1][0], 0, 0, 0); acc[1][1] = __builtin_amdgcn_mfma_f32_32x32x16_bf16(a1, b1, acc[1][1], 0, 0, 0); } \
        __syncthreads(); } } while (0)
#define RB_SCALE(tb) do { _Pragma("unroll") for (int ia = 0; ia < 2; ++ia) _Pragma("unroll") for (int r = 0; r < 16; ++r) { const float s_ = (tb)[wr2 * 64 + ia * 32 + crow(r, hi)]; acc[ia][0][r] *= s_; acc[ia][1][r] *= s_; } } while (0)
    if (has_f) {
        const bf16* sf = lat ? R.STL + ((size_t)(((b * 4 + h) * 2 + 0) * 8 + cc) << 16) : R.STC + ((size_t)((b * 4 + h) * 2 + 0) << 16);
        RB_STATE(sf); RB_SCALE(rtab);
    }
    if (has_b) {
        const bf16* sb = lat ? R.STL + ((size_t)(((b * 4 + h) * 2 + 1) * 8 + cc) << 16) : R.STC + ((size_t)((b * 4 + h) * 2 + 1) << 16);
        RB_STATE(sb);
    }
    RB_SCALE(rtab + CH);
    {
        const int ibq = wid & 3, jb0 = (wid >> 2) * 2, i = ibq * 32 + r32;
#pragma unroll
        for (int t = 0; t < 2; ++t)
#pragma unroll
            for (int g = 0; g < 4; ++g) { const int j0 = (jb0 + t) * 32 + 8 * g + 4 * hi;
                *(LAS v2u*)(RA + img_off(i, j0 >> 3) + (j0 & 7) * 2) = (v2u){pk[t][2 * g], pk[t][2 * g + 1]}; }
        const int sr = tid >> 4, sc = (tid & 15) * 8, st0 = v_st(sr, sc), st1 = v_st(32 + sr, sc);
        const bf16* Vg = R.RV + row0 * DM + h * 256 + sc;
#pragma unroll
        for (int th = 0; th < 2; ++th)
#pragma unroll
            for (int dh = 0; dh < 2; ++dh) { const bf16* vp = Vg + (long)(th * 64 + sr) * DM + dh * 128;
                *(LAS bf16x8*)(RB + (th * 2 + dh) * 16384 + st0) = *(const bf16x8*)vp; *(LAS bf16x8*)(RB + (th * 2 + dh) * 16384 + st1) = *(const bf16x8*)(vp + 32 * DM); }
    }
    __syncthreads();
    {
        const int vb = (int)(uintptr_t)RB + (wc4 >> 1) * 16384 + (wc4 & 1) * 1024 + v_rd_base(lane);
#define RB_PV(TH, KS) do { const int vbb = vb + (TH) * 32768; \
        const s16x4 b0l = tr_read<v_rd_off(0, KS, 0)>(vbb), b0h = tr_read<v_rd_off(0, KS, 1)>(vbb), b1l = tr_read<v_rd_off(1, KS, 0)>(vbb), b1h = tr_read<v_rd_off(1, KS, 1)>(vbb); \
        const bf16x8 a0 = frag(RA, wr2 * 64, (TH) * 4 + (KS), r32, hi), a1 = frag(RA, wr2 * 64 + 32, (TH) * 4 + (KS), r32, hi); \
        asm volatile("s_waitcnt lgkmcnt(0)" ::: "memory"); SBAR(); \
        const bf16x8 b0 = RET_PK(b0l, b0h), b1 = RET_PK(b1l, b1h); \
        acc[0][0] = __builtin_amdgcn_mfma_f32_32x32x16_bf16(a0, b0, acc[0][0], 0, 0, 0); acc[0][1] = __builtin_amdgcn_mfma_f32_32x32x16_bf16(a0, b1, acc[0][1], 0, 0, 0); \
        acc[1][0] = __builtin_amdgcn_mfma_f32_32x32x16_bf16(a1, b0, acc[1][0], 0, 0, 0); acc[1][1] = __builtin_amdgcn_mfma_f32_32x32x16_bf16(a1, b1, acc[1][1], 0, 0, 0); } while (0)
        RB_PV(0, 0); RB_PV(0, 1); RB_PV(0, 2); RB_PV(0, 3); RB_PV(1, 0); RB_PV(1, 1); RB_PV(1, 2); RB_PV(1, 3);
#undef RB_PV
    }
    __syncthreads();
    {
        LAS float* OL = (LAS float*)lds;
#pragma unroll
        for (int ia = 0; ia < 2; ++ia)
#pragma unroll
            for (int ib = 0; ib < 2; ++ib)
#pragma unroll
                for (int r = 0; r < 16; ++r) OL[(wr2 * 64 + ia * 32 + crow(r, hi)) * 256 + wc4 * 64 + ib * 32 + r32] = acc[ia][ib][r];
        __syncthreads();
        const int row = tid >> 2, qd = tid & 3; const LAS float* orow = OL + row * 256 + qd * 64;
        float s = 0.f;
#pragma unroll
        for (int k = 0; k < 16; ++k) { const f32x4 x = *(const LAS f32x4*)(orow + 4 * ((k + lane) & 15)); s += (x.x + x.y) + (x.z + x.w); }
        s += __shfl_xor(s, 1); s += __shfl_xor(s, 2);
        const float mu = s * (1.f / 256.f); float q = 0.f;
#pragma unroll
        for (int k = 0; k < 16; ++k) { const f32x4 x = *(const LAS f32x4*)(orow + 4 * ((k + lane) & 15)) - mu; q += (x.x * x.x + x.y * x.y) + (x.z * x.z + x.w * x.w); }
        q += __shfl_xor(q, 1); q += __shfl_xor(q, 2);
        const float rstd = rsqrtf(q * (1.f / 256.f) + EPS);
        const bf16* gp = R.RG + (row0 + row) * DM + h * 256 + qd * 64; bf16* op = R.RO + (row0 + row) * DM + h * 256 + qd * 64; const float* gw = R.gn_w + h * 256 + qd * 64;
#pragma unroll
        for (int k = 0; k < 8; ++k) { const int kk = (k + lane) & 7;
            const f32x4 x0 = (*(const LAS f32x4*)(orow + 8 * kk) - mu) * rstd * *(const f32x4*)(gw + 8 * kk), x1 = (*(const LAS f32x4*)(orow + 8 * kk + 4) - mu) * rstd * *(const f32x4*)(gw + 8 * kk + 4);
            const v4u g = *(const v4u*)(gp + 8 * kk);
            v4u w; w.x = cvtpk(x0.x * __builtin_bit_cast(float, g.x << 16), x0.y * __builtin_bit_cast(float, g.x & 0xffff0000u)); w.y = cvtpk(x0.z * __builtin_bit_cast(float, g.y << 16), x0.w * __builtin_bit_cast(float, g.y & 0xffff0000u));
            w.z = cvtpk(x1.x * __builtin_bit_cast(float, g.z << 16), x1.y * __builtin_bit_cast(float, g.z & 0xffff0000u)); w.w = cvtpk(x1.z * __builtin_bit_cast(float, g.w << 16), x1.w * __builtin_bit_cast(float, g.w & 0xffff0000u));
            *(v4u*)(op + 8 * kk) = w; }
    }
    __syncthreads();
#undef RB_STATE
#undef RB_SCALE
}
#undef SBAR
#undef RET_PK
}
#ifndef MK_N_LAUNCHES
#define MK_N_LAUNCHES 1
#endif
constexpr int N_PHASES = 13;
struct Args {
    const float* x_prompt; const float* x_sample; const float* cache_k; const float* cache_v; const float* state_ret; const float* c; const float* c_ctx;
    const float* w_mod; const float* b_mod; const float* norm_g; const float* attn_w_qkv; const float* attn_q_norm; const float* attn_k_norm; const float* attn_w_o;
    const float* ret_w_qkvg; const float* ret_decay_logit; const float* ret_gn_w; const float* ret_w_o; const float* mlp_w1; const float* mlp_w2; const float* final_norm_g;
    float* out; unsigned char* ws; int ph_lo, ph_hi;
};
constexpr size_t OUT_NCK = (size_t)MTOK * DM, OUT_NCV = OUT_NCK + (size_t)M_CTX * 256, OUT_NST = OUT_NCV + (size_t)M_CTX * 256;

__global__ void __launch_bounds__(NWAVES * 64, 2) fwd_kernel(Args a) {
    extern __shared__ __attribute__((aligned(16))) unsigned char lds_raw[];
    LAS unsigned char* lds = (LAS unsigned char*)lds_raw;
    volatile LAS unsigned* MISC = (volatile LAS unsigned*)(lds + MISC_OFF);
    const int tid = threadIdx.x, lane = tid & 63, wave = __builtin_amdgcn_readfirstlane(tid >> 6);
    const int G = gridDim.x, bx = blockIdx.x, vcu = (G % 8 == 0) ? (bx % 8) * (G / 8) + bx / 8 : bx;
    unsigned char* ws = a.ws;
    gu32* ctl = (gu32*)(ws + WS_CTL);
    float* MOD = (float*)(ws + CTL_MODACC);
    float* BQKV = (float*)(ws + CTL_BIAS); float* B1_0 = BQKV + NCOND * NQKV; float* BPROJ = B1_0 + NCOND * FFD; float* B1_1 = BPROJ + NCOND * FFD;
    float* ROWSQ = (float*)(ws + CTL_ROWSQ);
    float* TABA = (float*)(ws + WS_SMALL + SM_TABA); float* TABR = (float*)(ws + WS_SMALL + SM_TABR); float* GS = (float*)(ws + WS_SMALL + SM_GS); float* QNP = (float*)(ws + WS_SMALL + SM_QNP);
    bf16* WQKV_t = (bf16*)(ws + WS_WQKV); bf16* WO_t = (bf16*)(ws + WS_WO); bf16* W1_t0 = (bf16*)(ws + WS_W1_0); bf16* W2_t0 = (bf16*)(ws + WS_W2_0);
    bf16* RETW_t = (bf16*)(ws + WS_RETW); bf16* RETWO_t = (bf16*)(ws + WS_RETWO); bf16* W1_t1 = (bf16*)(ws + WS_W1_1); bf16* W2_t1 = (bf16*)(ws + WS_W2_1);
    bf16* AB = (bf16*)(ws + WS_A); bf16* QB = (bf16*)(ws + WS_Q); bf16* KC = (bf16*)(ws + WS_KC); bf16* VC = (bf16*)(ws + WS_VC); bf16* KL = (bf16*)(ws + WS_KL); bf16* VL = (bf16*)(ws + WS_VL);
    bf16* HFF = (bf16*)(ws + WS_HFF); bf16* RQ = (bf16*)(ws + WS_RQ); bf16* RK = (bf16*)(ws + WS_RK); bf16* RV = (bf16*)(ws + WS_RV); bf16* RG = (bf16*)(ws + WS_RG); bf16* RO = (bf16*)(ws + WS_RO);
    bf16* STC = (bf16*)(ws + WS_STC); bf16* STL = (bf16*)(ws + WS_STL);
    float* XR = a.out;
    for (int u = tid; u < (XCH_OFF - LDSCTL_OFF) / 4; u += NWAVES * 64) ((LAS unsigned*)(lds + LDSCTL_OFF))[u] = 0u;
    __syncthreads();
    XcdBarrier bar; bar.bar = (unsigned*)(ctl + CW_BAR); bar.x = 0; bar.st = nullptr;
    if (MK_N_LAUNCHES == 1) bar = xcd_barrier_post((unsigned*)(ctl + CW_BAR), MISC + 8);
    const int lo = a.ph_lo, hi = a.ph_hi;
#define IN(k) (lo <= (k) && (k) < hi)
#define SEAM(k) do { if (IN(k) && IN((k) + 1)) xcd_barrier(bar); } while (0)
    const int gw = vcu * NWAVES + wave, NGW = G * NWAVES;
    const int gt = (vcu * NWAVES + wave) * 64 + lane, NGT = NGW * 64;
    LAS float* scr = (LAS float*)(lds + wave * 16384);

    if (IN(0)) {
        for (int it = gw; it < 2 * 24 * 16; it += NGW) { const int L = it / 384, r = it % 384, ng = r / 16, kc = r % 16;
            p0_gemv_item<0, 0>(a.w_mod + (size_t)L * DM * 6144, 6144, ng * 256, kc * 64, nullptr, 0, a.c_ctx, a.c, MOD + (size_t)L * NCOND * 6144, 6144, a.b_mod + L * 6144, scr, lane); }
        constexpr int I_QKV = 16 * 48, I_WO = 16 * 32, I_W1 = 16 * 128, I_W2 = 64 * 32, I_RW = 16 * 128;
        constexpr int NIT = I_QKV + 2 * I_WO + 2 * I_W1 + 2 * I_W2 + I_RW;
        for (int it = gw; it < NIT; it += NGW) { int r = it;
            if (r < I_QKV) { p0_transpose_item<1>(a.attn_w_qkv, DM, NQKV, WQKV_t, scr, r, lane); continue; } r -= I_QKV;
            if (r < I_WO) { p0_transpose_item<0>(a.attn_w_o, DM, DM, WO_t, scr, r, lane); continue; } r -= I_WO;
            if (r < I_WO) { p0_transpose_item<0>(a.ret_w_o, DM, DM, RETWO_t, scr, r, lane); continue; } r -= I_WO;
            if (r < I_W1) { p0_transpose_item<0>(a.mlp_w1, DM, FFD, W1_t0, scr, r, lane); continue; } r -= I_W1;
            if (r < I_W1) { p0_transpose_item<0>(a.mlp_w1 + (size_t)DM * FFD, DM, FFD, W1_t1, scr, r, lane); continue; } r -= I_W1;
            if (r < I_W2) { p0_transpose_item<0>(a.mlp_w2, FFD, DM, W2_t0, scr, r, lane); continue; } r -= I_W2;
            if (r < I_W2) { p0_transpose_item<0>(a.mlp_w2 + (size_t)DM * FFD, FFD, DM, W2_t1, scr, r, lane); continue; } r -= I_W2;
            p0_transpose_item<2>(a.ret_w_qkvg, DM, NRETP, RETW_t, scr, r, lane);
        }
        for (int i = gt; i < 2 * NB_LAT * PAST * 32; i += NGT) { const int isv = i >= NB_LAT * PAST * 32, j = isv ? i - NB_LAT * PAST * 32 : i;
            const int c8 = j & 31, t = (j >> 5) & (PAST - 1), b = j >> 14; const float* src = (isv ? a.cache_v : a.cache_k) + ((size_t)(b * PAST + t) * 256);
            float v[8];
#pragma unroll
            for (int e = 0; e < 8; ++e) { const int col = c8 * 8 + e; v[e] = src[isv ? col : (col & ~127) + dimA(col & 127)]; }
            v4u w; w.x = pk2(v[0], v[1]); w.y = pk2(v[2], v[3]); w.z = pk2(v[4], v[5]); w.w = pk2(v[6], v[7]);
            *(v4u*)((isv ? VL : KL) + ((size_t)b * KVL + t) * 256 + c8 * 8) = w; }
        for (int i = gt; i < S_LAT * 64; i += NGT) { const int pos = i >> 6, q = i & 63, hf = q >> 5, ii = q & 31;
            const float fr = exp2f(-(float)ii * (13.287712379549449f / 32.f)); const float ang = (float)(hf ? (pos & 63) : (pos >> 6)) * fr; float sn, cs; sincosf(ang, &sn, &cs);
            TABA[2 * i] = cs; TABA[2 * i + 1] = sn; }
        for (int i = gt; i < S_LAT * 128; i += NGT) { const int pos = i >> 7, q = i & 127, hf = q >> 6, ii = q & 63;
            const float fr = exp2f(-(float)ii * (13.287712379549449f / 64.f)); const float ang = (float)(hf ? (pos & 63) : (pos >> 6)) * fr; float sn, cs; sincosf(ang, &sn, &cs);
            TABR[2 * i] = cs; TABR[2 * i + 1] = sn; }
        if (gt < 256) QNP[gt] = (gt < 128 ? a.attn_q_norm : a.attn_k_norm)[dimA(gt & 127)];
    }
    SEAM(0);
    if (IN(1)) {
        for (int i = gt; i < 2 * 2 * NCOND * DM; i += NGT) { const int k = i & (DM - 1), ci = (i >> 10) % NCOND, wh = (i / (NCOND * DM)) & 1, L = i / (2 * NCOND * DM);
            GS[i] = a.norm_g[(L * 2 + wh) * DM + k] * (1.f + MOD[((size_t)L * NCOND + ci) * 6144 + (wh ? 4 : 1) * DM + k]); }
        for (int it = gw; it < 96 + 3 * 256; it += NGW) {
            if (it < 96) { p0_gemv_item<1, 1>(a.attn_w_qkv, NQKV, (it / 16) * 256, (it % 16) * 64, MOD, 6144, nullptr, nullptr, BQKV, NQKV, nullptr, scr, lane); continue; }
            const int r = it - 96, m = r / 256, q = r % 256, n0 = (q / 16) * 256, k0 = (q % 16) * 64;
            if (m == 0) p0_gemv_item<0, 1>(a.mlp_w1, FFD, n0, k0, MOD + 3 * DM, 6144, nullptr, nullptr, B1_0, FFD, nullptr, scr, lane);
            else if (m == 1) p0_gemv_item<2, 1>(a.ret_w_qkvg, NRETP, n0, k0, MOD + (size_t)NCOND * 6144, 6144, nullptr, nullptr, BPROJ, NRETP, nullptr, scr, lane);
            else p0_gemv_item<0, 1>(a.mlp_w1 + (size_t)DM * FFD, FFD, n0, k0, MOD + (size_t)NCOND * 6144 + 3 * DM, 6144, nullptr, nullptr, B1_1, FFD, nullptr, scr, lane);
        }
        for (int m = gw; m < MTOK; m += NGW) {
            const int ci = m < M_CTX ? 0 : 1 + ((m - M_CTX) >> 10);
            const float* xrow = m < M_CTX ? a.x_prompt + (size_t)m * DM : a.x_sample + (size_t)(m - M_CTX) * DM;
            const float* sc = MOD + (size_t)ci * 6144 + DM; float s = 0.f;
#pragma unroll
            for (int j = 0; j < 4; ++j) { const int k = 4 * lane + 256 * j; const f32x4 x = *(const f32x4*)(xrow + k), g = *(const f32x4*)(a.norm_g + k), sv = *(const f32x4*)(sc + k);
                s += (x.x * x.x + x.y * x.y) + (x.z * x.z + x.w * x.w); const f32x4 y = x * g * (sv + 1.f);
                v2u w; w.x = cvtpk(y.x, y.y); w.y = cvtpk(y.z, y.w); *(v2u*)(AB + (size_t)m * DM + k) = w; }
            s = wave_sum(s); if (lane == 0) ROWSQ[m] = s;
        }
    }
    SEAM(1);
    if (IN(2)) {
        pg8::Gemm g{AB, WQKV_t, MTOK, NQKV, DM}; pg8::StaticOrder S; S.init(MTOK, NQKV, G, bx);
        EpiQKV E{ROWSQ, BQKV, QNP, TABA, QB, KC, VC, KL, VL, a.out + OUT_NCK, a.out + OUT_NCV, (LAS float*)(lds + XCH_OFF)};
        pg8::gemm_phase<EpiQKV, pg8::StaticOrder, true, true>(lds, g, S, E);
    }
    SEAM(2);
    if (IN(3)) {
        { const int grp = vcu >> 4, w16 = vcu & 15, b = grp >> 1, head = (grp & 1) * 4 + (w16 >> 2), qb = w16 & 3;
          const size_t qoff = ((size_t)M_CTX + (size_t)b * S_LAT + qb * 256) * DM + head * 128, koff = ((size_t)b * KVL) * 256 + (head >> 2) * 128;
          if (vcu < 256) att::attn_unit(QB + qoff, KL + koff, VL + koff, QB + qoff, KVL, (char*)lds_raw); }
        if (vcu < 128) { const int b = vcu >> 3, head = vcu & 7; const size_t qoff = ((size_t)b * S_CTX) * DM + head * 128, koff = ((size_t)b * S_CTX) * 256 + (head >> 2) * 128;
          att::attn_unit(QB + qoff, KC + koff, VC + koff, QB + qoff, S_CTX, (char*)lds_raw); }
    }
    SEAM(3);
    if (IN(4)) {
        pg8::Gemm g{QB, WO_t, MTOK, DM, DM}; pg8::StaticOrder S; S.init(MTOK, DM, G, bx);
        EpiRes E{a.x_prompt, a.x_sample, XR, AB, MOD + 2 * DM, GS + (size_t)(0 * 2 + 1) * NCOND * DM, ROWSQ + 1 * MTOK};
        pg8::gemm_phase<EpiRes, pg8::StaticOrder, true, true>(lds, g, S, E);
    }
    SEAM(4);
    if (IN(5)) {
        pg8::Gemm g{AB, W1_t0, MTOK, FFD, DM}; pg8::StaticOrder S; S.init(MTOK, FFD, G, bx);
        EpiMlp1 E{ROWSQ + 1 * MTOK, B1_0, HFF};
        pg8::gemm_phase<EpiMlp1, pg8::StaticOrder, true, true>(lds, g, S, E);
    }
    SEAM(5);
    if (IN(6)) {
        pg8::Gemm g{HFF, W2_t0, MTOK, DM, FFD}; pg8::StaticOrder S; S.init(MTOK, DM, G, bx);
        EpiRes E{XR, XR + (size_t)M_CTX * DM, XR, AB, MOD + 5 * DM, GS + (size_t)(1 * 2 + 0) * NCOND * DM, ROWSQ + 2 * MTOK};
        pg8::gemm_phase<EpiRes, pg8::StaticOrder, true, true>(lds, g, S, E);
    }
    SEAM(6);
    if (IN(7)) {
        pg8::Gemm g{AB, RETW_t, MTOK, NRETP, DM}; pg8::StaticOrder S; S.init(MTOK, NRETP, G, bx);
        EpiProj E{ROWSQ + 2 * MTOK, BPROJ, TABR, RQ, RK, RV, RG};
        pg8::gemm_phase<EpiProj, pg8::StaticOrder, true, true>(lds, g, S, E);
    }
    SEAM(7);
    if (IN(8)) {
        const ret::RetAArgs R{RK, RV, a.state_ret, a.ret_decay_logit, STC, STL, a.out + OUT_NST};
        if (vcu < 128) ret::retA_unit(R, 1, vcu >> 4, (vcu >> 2) & 3, (vcu >> 1) & 1, vcu & 1, lds);
        else if (vcu < 256) { for (int t = 0; t < 2; ++t) { const int u = (vcu - 128) * 2 + t; ret::retA_unit(R, 0, u >> 4, (u >> 2) & 3, (u >> 1) & 1, u & 1, lds); } }
    }
    SEAM(8);
    if (IN(9)) {
        const ret::RetBArgs R{RQ, RK, RV, RG, STC, STL, a.ret_decay_logit, a.ret_gn_w, RO};
        if (vcu < 256) ret::retB_unit(R, 1, vcu >> 5, (vcu >> 3) & 3, vcu & 7, lds);
        if (vcu < 128) ret::retB_unit(R, 0, vcu >> 3, (vcu >> 1) & 3, vcu & 1, lds);
    }
    SEAM(9);
    if (IN(10)) {
        pg8::Gemm g{RO, RETWO_t, MTOK, DM, DM}; pg8::StaticOrder S; S.init(MTOK, DM, G, bx);
        EpiRes E{XR, XR + (size_t)M_CTX * DM, XR, AB, MOD + (size_t)NCOND * 6144 + 2 * DM, GS + (size_t)(1 * 2 + 1) * NCOND * DM, ROWSQ + 3 * MTOK};
        pg8::gemm_phase<EpiRes, pg8::StaticOrder, true, true>(lds, g, S, E);
    }
    SEAM(10);
    if (IN(11)) {
        pg8::Gemm g{AB, W1_t1, MTOK, FFD, DM}; pg8::StaticOrder S; S.init(MTOK, FFD, G, bx);
        EpiMlp1 E{ROWSQ + 3 * MTOK, B1_1, HFF};
        pg8::gemm_phase<EpiMlp1, pg8::StaticOrder, true, true>(lds, g, S, E);
    }
    SEAM(11);
    if (IN(12)) {
        pg8::Gemm g{HFF, W2_t1, MTOK, DM, FFD}; pg8::StaticOrder S; S.init(MTOK, DM, G, bx);
        EpiRes E{XR, XR + (size_t)M_CTX * DM, XR, nullptr, MOD + (size_t)NCOND * 6144 + 5 * DM, nullptr, ROWSQ + 4 * MTOK};
        pg8::gemm_phase<EpiRes, pg8::StaticOrder, true, true>(lds, g, S, E);
    }
    SEAM(12);
    if (IN(13)) {
        for (int m = gw; m < MTOK; m += NGW) { const float rs = rsqrtf(ROWSQ[4 * MTOK + m] * (1.f / DM) + EPS); float* xrow = XR + (size_t)m * DM;
#pragma unroll
            for (int j = 0; j < 4; ++j) { const int k = 4 * lane + 256 * j; *(f32x4*)(xrow + k) = *(const f32x4*)(xrow + k) * rs * *(const f32x4*)(a.final_norm_g + k); } }
    }
#undef IN
#undef SEAM
}

extern "C" void kernel_launch(void* const* d_in, const int* in_sizes, int n_in, void* d_out, int out_size, void* d_ws, size_t ws_size, hipStream_t stream) {
    static int grid = 0;
    if (grid == 0) {
        if (n_in != 21 || in_sizes[0] != M_CTX * DM || in_sizes[1] != M_LAT * DM || ws_size < WS_END) { fprintf(stderr, "kernel_launch: unexpected shapes (n_in %d, ws %zu); nothing launched\n", n_in, ws_size); grid = -1; return; }
        int dev = 0, cus = 0, per_cu = 0;
        if (hipGetDevice(&dev) != hipSuccess || hipDeviceGetAttribute(&cus, hipDeviceAttributeMultiprocessorCount, dev) != hipSuccess) { grid = -1; return; }
        if (hipFuncSetAttribute((const void*)fwd_kernel, hipFuncAttributeMaxDynamicSharedMemorySize, LDS_BYTES) != hipSuccess) { fprintf(stderr, "kernel_launch: hipFuncSetAttribute failed\n"); grid = -1; return; }
        if (hipOccupancyMaxActiveBlocksPerMultiprocessor(&per_cu, (const void*)fwd_kernel, NWAVES * 64, LDS_BYTES) != hipSuccess || per_cu < 1) fprintf(stderr, "kernel_launch: occupancy query reports %d blocks per CU\n", per_cu);
        (void)hipGetLastError();
        grid = cus;
        if (grid != 256) fprintf(stderr, "kernel_launch: %d CUs (built for 256)\n", grid);
    }
    if (grid < 0) return;
    (void)hipMemsetAsync((char*)d_ws + WS_CTL, 0, CTL_ZERO_BYTES, stream);
    Args a{};
    a.x_prompt = (const float*)d_in[0]; a.x_sample = (const float*)d_in[1]; a.cache_k = (const float*)d_in[2]; a.cache_v = (const float*)d_in[3]; a.state_ret = (const float*)d_in[4];
    a.c = (const float*)d_in[5]; a.c_ctx = (const float*)d_in[6]; a.w_mod = (const float*)d_in[7]; a.b_mod = (const float*)d_in[8]; a.norm_g = (const float*)d_in[9];
    a.attn_w_qkv = (const float*)d_in[10]; a.attn_q_norm = (const float*)d_in[11]; a.attn_k_norm = (const float*)d_in[12]; a.attn_w_o = (const float*)d_in[13];
    a.ret_w_qkvg = (const float*)d_in[14]; a.ret_decay_logit = (const float*)d_in[15]; a.ret_gn_w = (const float*)d_in[16]; a.ret_w_o = (const float*)d_in[17];
    a.mlp_w1 = (const float*)d_in[18]; a.mlp_w2 = (const float*)d_in[19]; a.final_norm_g = (const float*)d_in[20];
    a.out = (float*)d_out; a.ws = (unsigned char*)d_ws;
#if MK_N_LAUNCHES == 1
    a.ph_lo = 0; a.ph_hi = N_PHASES + 1;
    hipLaunchKernelGGL(fwd_kernel, dim3(grid), dim3(NWAVES * 64), LDS_BYTES, stream, a);
#else
    for (int p = 0; p <= N_PHASES; ++p) { a.ph_lo = p; a.ph_hi = p + 1; hipLaunchKernelGGL(fwd_kernel, dim3(grid), dim3(NWAVES * 64), LDS_BYTES, stream, a); }
#endif
    const hipError_t le = hipPeekAtLastError();
    if (le != hipSuccess) fprintf(stderr, "kernel_launch: launch failed: %s\n", hipGetErrorName(le));
}
```

```cpp
#include <hip/hip_runtime.h>
#include <cstdio>
#include <cstdint>

constexpr int DM = 1024, FFD = 4096;
constexpr int NB_CTX = 16, S_CTX = 256, NB_LAT = 8, S_LAT = 1024, PAST = 512;
constexpr int M_CTX = NB_CTX * S_CTX;
constexpr int M_LAT = NB_LAT * S_LAT;
constexpr int MTOK = M_CTX + M_LAT;
constexpr int NQKV = 1536, NRETP = 4096;
constexpr int NCOND = 9;
constexpr int KVL = PAST + S_LAT;
constexpr float EPS = 1e-6f;
constexpr int NWAVES = 8;

constexpr size_t MiB = 1u << 20;
constexpr size_t WS_CTL = 0, CTL_ZERO_BYTES = 2 * MiB;
constexpr size_t CTL_MODACC = 64 * 1024;
constexpr size_t CTL_BIAS = 512 * 1024;
constexpr size_t CTL_ROWSQ = 1 * MiB;
constexpr size_t CTL_PCNT = 1792 * 1024;
constexpr size_t WS_SMALL = 2 * MiB;
constexpr size_t SM_TABA = 0;
constexpr size_t SM_TABR = 512 * 1024;
constexpr size_t SM_GS = 1536 * 1024;
constexpr size_t SM_QNP = SM_GS + 2 * 2 * 9 * 1024 * 4;
constexpr size_t WS_RETWO = 4 * MiB, WS_W1_1 = 6 * MiB, WS_W2_1 = 14 * MiB;
constexpr size_t WS_WQKV = 22 * MiB, WS_WO = 25 * MiB, WS_W1_0 = 27 * MiB, WS_W2_0 = 35 * MiB, WS_RETW = 43 * MiB;
constexpr size_t WS_A = 51 * MiB, WS_Q = 75 * MiB, WS_KC = 99 * MiB, WS_VC = 101 * MiB, WS_KL = 103 * MiB, WS_VL = 109 * MiB;
constexpr size_t WS_STC = 235 * MiB, WS_STLF = 75 * MiB;
constexpr size_t WS_HFF = 115 * MiB, WS_RQ = 115 * MiB, WS_RK = 139 * MiB, WS_RV = 163 * MiB, WS_RG = 187 * MiB;
constexpr size_t WS_RO = 211 * MiB, WS_END = 251 * MiB;
static_assert(WS_RK == WS_RQ + 24 * MiB && WS_RV == WS_RK + 24 * MiB && WS_RG == WS_RV + 24 * MiB && WS_STLF + 32 * MiB <= WS_HFF && WS_STC + 16 * MiB <= 256 * MiB && WS_VL + 6 * MiB <= WS_HFF && WS_RG + 24 * MiB <= WS_RO, "d_ws map");
constexpr size_t OUT_NST_F = (size_t)MTOK * DM + 2 * (size_t)M_CTX * 256;
constexpr int CW_BAR = 4096;

constexpr int RING_BYTES = 131072;
constexpr int LDSCTL_OFF = RING_BYTES, MISC_OFF = LDSCTL_OFF + 320;
constexpr int XCH_OFF = RING_BYTES + 1024;
constexpr int LDS_BYTES = XCH_OFF + 20480;

#define GAS __attribute__((address_space(1)))
#define LAS __attribute__((address_space(3)))
typedef unsigned short bf16;
typedef unsigned v4u __attribute__((ext_vector_type(4)));
typedef unsigned v2u __attribute__((ext_vector_type(2)));
typedef float f32x4 __attribute__((ext_vector_type(4)));
typedef float f32x2 __attribute__((ext_vector_type(2)));
typedef float f32x16 __attribute__((ext_vector_type(16)));
typedef short bf16x8 __attribute__((ext_vector_type(8)));
typedef short s16x4 __attribute__((ext_vector_type(4)));
typedef GAS unsigned gu32;
typedef GAS unsigned long long gu64;
#define RLX_AGENT __ATOMIC_RELAXED, __HIP_MEMORY_SCOPE_AGENT
#define LDS_WAIT() asm volatile("s_waitcnt lgkmcnt(0)" ::: "memory")
#define VM_WAIT() asm volatile("s_waitcnt vmcnt(0)" ::: "memory")
__device__ __forceinline__ unsigned f2bf(float f) { unsigned u = __builtin_bit_cast(unsigned, f); return (u + 0x7fffu + ((u >> 16) & 1u)) >> 16; }
__device__ __forceinline__ unsigned pk2(float lo, float hi) { return f2bf(lo) | (f2bf(hi) << 16); }
__device__ __forceinline__ float bf2f(unsigned short b) { return __builtin_bit_cast(float, ((unsigned)b) << 16); }
__device__ __forceinline__ unsigned cvtpk(float lo, float hi) { unsigned r; asm volatile("v_cvt_pk_bf16_f32 %0, %1, %2" : "=v"(r) : "v"(lo), "v"(hi)); return r; }

__host__ __device__ __forceinline__ int posA(int d) { const int half = d >> 6, m = (d >> 5) & 1, i = d & 31; return 2 * (half * 32 + i) + m; }
__host__ __device__ __forceinline__ int dimA(int p) { const int q = p >> 1, m = p & 1, half = q >> 5, i = q & 31; return half * 64 + m * 32 + i; }
__host__ __device__ __forceinline__ int posR(int d) { const int half = d >> 7, m = (d >> 6) & 1, i = d & 63; return 2 * (half * 64 + i) + m; }
__host__ __device__ __forceinline__ int dimR(int p) { const int q = p >> 1, m = p & 1, half = q >> 6, i = q & 63; return half * 128 + m * 64 + i; }
namespace pg8 {
#define PG8_LAS __attribute__((address_space(3)))
typedef unsigned short bf16_t;
typedef short bf16x8 __attribute__((ext_vector_type(8)));
typedef float f32x4 __attribute__((ext_vector_type(4)));
typedef unsigned u32x4 __attribute__((ext_vector_type(4)));
constexpr int BM = 256, BK = 64, HALF = 128, HTB = HALF * BK * 2  , STAGE_BYTES = 8 * HTB, NXCD = 8, WGM = 8;

__host__ __device__ __forceinline__ int lds_byte(int r, int c) { const int st = (r >> 4) * 2 + (c >> 5), rr = r & 15, cc = c & 31, ob = rr * 64 + cc * 2; return st * 1024 + (ob ^ (((ob >> 9) & 1) << 5)); }
__host__ __device__ __forceinline__ void stage_rc(int b, int& R, int& C) { const int st = b / 1024, sb = b % 1024, swz = sb ^ (((sb >> 9) & 1) << 5); R = (st >> 1) * 16 + swz / 64; C = (st & 1) * 32 + (swz % 64) / 2; }
__host__ __device__ __forceinline__ int perm32(int rho) { const int n = rho >> 4, i = rho & 15; return 8 * (i >> 2) + 4 * n + (i & 3); }

struct Unit { int pm, pn; };
struct Gemm { const bf16_t* A; const bf16_t* Bt; int M, N, K; };

struct StaticOrder {
    int nM, nN, nwg, G, c;
    __host__ __device__ void init(int M, int N, int G_, int c_, int bm = BM) { nM = M / bm; nN = N / BM; nwg = nM * nN; G = G_; c = c_; }
    __host__ __device__ bool next(int i, Unit& u) const {
        const long L = (long)i * G + c; if (L >= nwg) return false;
        int wgid = (int)L; { const int q = nwg / NXCD, r = nwg % NXCD, xcd = wgid % NXCD, off = wgid / NXCD; wgid = (xcd < r ? xcd * (q + 1) : r * (q + 1) + (xcd - r) * q) + off; }
        const int nig = WGM * nN, gid = wgid / nig, fm = gid * WGM, gsz = (nM - fm) < WGM ? (nM - fm) : WGM;
        u.pm = fm + ((wgid % nig) % gsz); u.pn = (wgid % nig) / gsz; return true;
    }
    __device__ __forceinline__ void a_ready(const Unit&) const {}
    __device__ __forceinline__ void done(const Unit&) const {}
};
__device__ __forceinline__ unsigned cvt_pk_bf16(float lo, float hi) { unsigned r; asm volatile("v_cvt_pk_bf16_f32 %0, %1, %2" : "=v"(r) : "v"(lo), "v"(hi)); return r; }

template <class Epi, class Sched, bool ALIGN_EPI = false, bool SP2 = false, int MT = 4  >
__device__ __forceinline__ void gemm_phase(PG8_LAS unsigned char* lds, const Gemm g, const Sched& S, const Epi& E) {
    const int tid = threadIdx.x, wid = __builtin_amdgcn_readfirstlane(tid >> 6), lane = tid & 63, wr = wid >> 2, wc = wid & 3, fr = lane & 15, fq = lane >> 4;
    const int K = g.K, nt = K / BK;
    unsigned voffA[2], voffB[2];
#pragma unroll
    for (int i = 0; i < 2; ++i) { int R, C; stage_rc(tid * 16 + i * 8192, R, C); const int Rb = Epi::PERM ? ((R & ~31) + perm32(R & 31)) : R;
        voffA[i] = (unsigned)(R * K + C) * 2u; voffB[i] = (unsigned)(Rb * K + C) * 2u; }
    const size_t kstep = (size_t)(BK * 2);
    const size_t hstep = (size_t)HALF * K * 2;
    const size_t tstep = 2 * hstep; const size_t hstepA = (size_t)(32 * MT) * K * 2, tstepA = 2 * hstepA;
    const unsigned ldsw = (unsigned)wid * 1024u;
    const int aoff = lds_byte(wr * (16 * MT) + fr, fq * 8), boff = lds_byte(wc * 32 + fr, fq * 8);
#define PG8_SA(b, h) (((b) * 2 + (h)) * HTB)
#define PG8_SB(b, h) ((4 + (b) * 2 + (h)) * HTB)
#define PG8_STAGE(bufoff, gbase, voff) do { _Pragma("unroll") for (int _i = 0; _i < 2; ++_i) \
        __builtin_amdgcn_global_load_lds((const unsigned*)((const char*)(gbase) + (voff)[_i]), (PG8_LAS unsigned*)(lds + (bufoff) + ldsw + _i * 8192), 16, 0, 0); } while (0)
#define PG8_LDA(dst, b, h) do { _Pragma("unroll") for (int m = 0; m < MT; ++m) _Pragma("unroll") for (int k = 0; k < 2; ++k) dst[m][k] = *(const PG8_LAS bf16x8*)(lds + PG8_SA(b, h) + aoff + m * 2048 + k * 1024); } while (0)
#define PG8_LDB(dst, b, h) do { _Pragma("unroll") for (int n = 0; n < 2; ++n) _Pragma("unroll") for (int k = 0; k < 2; ++k) dst[n][k] = *(const PG8_LAS bf16x8*)(lds + PG8_SB(b, h) + boff + n * 2048 + k * 1024); } while (0)
#define PG8_MMA(ai, bj, At, Bt) do { __builtin_amdgcn_s_setprio(1); _Pragma("unroll") for (int m = 0; m < MT; ++m) _Pragma("unroll") for (int n = 0; n < 2; ++n) _Pragma("unroll") for (int k = 0; k < 2; ++k) \
        acc[ai][bj][m][n] = __builtin_amdgcn_mfma_f32_16x16x32_bf16(Bt[n][k], At[m][k], acc[ai][bj][m][n], 0, 0, 0); __builtin_amdgcn_s_setprio(0); } while (0)
#define PG8_WAIT_V(n) asm volatile("s_waitcnt vmcnt(" #n ")" ::: "memory")
#define PG8_WAIT_L(n) asm volatile("s_waitcnt lgkmcnt(" #n ")" ::: "memory")
#define PG8_BAR __builtin_amdgcn_s_barrier()
#define PG8_SCHED __builtin_amdgcn_sched_barrier(0)
    Unit cur, nxt; int ui = 0;
    if (!S.next(0, cur)) return;
    f32x4 acc[2][2][MT][2];
#pragma unroll
    for (int a = 0; a < 2; ++a)
#pragma unroll
        for (int b = 0; b < 2; ++b)
#pragma unroll
            for (int m = 0; m < MT; ++m)
#pragma unroll
                for (int n = 0; n < 2; ++n) acc[a][b][m][n] = (f32x4){0.f, 0.f, 0.f, 0.f};
    bf16x8 At[MT][2], B0[2][2], B1[2][2];
    const char* cA = (const char*)g.A + (size_t)cur.pm * tstepA; const char* cB = (const char*)g.Bt + (size_t)cur.pn * tstep;
    S.a_ready(cur);
    if constexpr (SP2) {
        PG8_STAGE(PG8_SB(0, 0), cB, voffB); PG8_STAGE(PG8_SB(0, 1), cB + hstep, voffB); PG8_STAGE(PG8_SA(0, 0), cA, voffA); PG8_STAGE(PG8_SA(0, 1), cA + hstepA, voffA);
        if (wr == 1) PG8_BAR;
        PG8_WAIT_V(2); PG8_BAR;
        PG8_STAGE(PG8_SB(1, 0), cB + kstep, voffB); PG8_STAGE(PG8_SB(1, 1), cB + hstep + kstep, voffB);
        PG8_WAIT_V(4); PG8_BAR;
    } else {
        PG8_STAGE(PG8_SB(0, 0), cB, voffB); PG8_STAGE(PG8_SA(0, 0), cA, voffA); PG8_STAGE(PG8_SB(0, 1), cB + hstep, voffB); PG8_STAGE(PG8_SA(0, 1), cA + hstepA, voffA);
        if (wr == 1) PG8_BAR;
        PG8_WAIT_V(4); PG8_BAR;
        PG8_STAGE(PG8_SB(1, 0), cB + kstep, voffB); PG8_STAGE(PG8_SA(1, 0), cA + kstep, voffA); PG8_STAGE(PG8_SB(1, 1), cB + hstep + kstep, voffB);
        PG8_WAIT_V(6); PG8_BAR;
    }
    for (;;) {
        const bool has_next = S.next(ui + 1, nxt);
        const char* nA = has_next ? (const char*)g.A + (size_t)nxt.pm * tstepA : cA; const char* nB = has_next ? (const char*)g.Bt + (size_t)nxt.pn * tstep : cB;
        for (int t = 0; t < nt; t += 2) {
            const bool last = (t == nt - 2);
            const char* a1 = cA + (size_t)(t + 1) * kstep;
            const char* a2 = last ? nA : cA + (size_t)(t + 2) * kstep; const char* b2 = last ? nB : cB + (size_t)(t + 2) * kstep;
            const char* a3 = a2 + kstep; (void)a3; const char* b3 = b2 + kstep;
            if (last && has_next) S.a_ready(nxt);
            if constexpr (SP2) {
            PG8_LDB(B0, 0, 0); PG8_LDB(B1, 0, 1); PG8_SCHED; PG8_LDA(At, 0, 0); PG8_STAGE(PG8_SA(1, 0), a1, voffA); PG8_STAGE(PG8_SA(1, 1), a1 + hstepA, voffA);
            PG8_WAIT_V(8); PG8_WAIT_L(0); PG8_BAR; PG8_MMA(0, 0, At, B0); PG8_MMA(0, 1, At, B1); PG8_BAR; PG8_SCHED;
            PG8_LDA(At, 0, 1); PG8_STAGE(PG8_SB(0, 0), b2, voffB); PG8_STAGE(PG8_SB(0, 1), b2 + hstep, voffB);
            PG8_WAIT_V(6); PG8_WAIT_L(0); PG8_BAR; PG8_MMA(1, 0, At, B0); PG8_MMA(1, 1, At, B1); PG8_BAR; PG8_SCHED;
            PG8_LDB(B0, 1, 0); PG8_LDB(B1, 1, 1); PG8_SCHED; PG8_LDA(At, 1, 0); PG8_STAGE(PG8_SA(0, 0), a2, voffA); PG8_STAGE(PG8_SA(0, 1), a2 + hstepA, voffA);
            PG8_WAIT_V(8); PG8_WAIT_L(0); PG8_BAR; PG8_MMA(0, 0, At, B0); PG8_MMA(0, 1, At, B1); PG8_BAR; PG8_SCHED;
            PG8_LDA(At, 1, 1); PG8_STAGE(PG8_SB(1, 0), b3, voffB); PG8_STAGE(PG8_SB(1, 1), b3 + hstep, voffB);
            PG8_WAIT_V(6); PG8_WAIT_L(0); PG8_BAR; PG8_MMA(1, 0, At, B0); PG8_MMA(1, 1, At, B1); PG8_BAR; PG8_SCHED;
            } else {
            PG8_LDB(B0, 0, 0); PG8_SCHED; PG8_LDA(At, 0, 0); PG8_STAGE(PG8_SA(1, 1), a1 + hstepA, voffA);
            PG8_WAIT_L(8); PG8_BAR; PG8_WAIT_L(0); PG8_MMA(0, 0, At, B0); PG8_BAR; PG8_SCHED;
            PG8_LDB(B1, 0, 1); PG8_STAGE(PG8_SB(0, 0), b2, voffB);
            PG8_BAR; PG8_WAIT_L(0); PG8_MMA(0, 1, At, B1); PG8_BAR;
            PG8_LDA(At, 0, 1); PG8_STAGE(PG8_SA(0, 0), a2, voffA);
            PG8_BAR; PG8_WAIT_L(0); PG8_MMA(1, 0, At, B0); PG8_BAR; PG8_SCHED;
            PG8_STAGE(PG8_SB(0, 1), b2 + hstep, voffB);
            PG8_WAIT_V(6); PG8_BAR; PG8_MMA(1, 1, At, B1); PG8_BAR;
            PG8_LDB(B0, 1, 0); PG8_SCHED; PG8_LDA(At, 1, 0); PG8_STAGE(PG8_SA(0, 1), a2 + hstepA, voffA);
            PG8_WAIT_L(8); PG8_BAR; PG8_WAIT_L(0); PG8_MMA(0, 0, At, B0); PG8_BAR; PG8_SCHED;
            PG8_LDB(B1, 1, 1); PG8_STAGE(PG8_SB(1, 0), b3, voffB);
            PG8_BAR; PG8_WAIT_L(0); PG8_MMA(0, 1, At, B1); PG8_BAR;
            PG8_LDA(At, 1, 1); PG8_STAGE(PG8_SA(1, 0), a3, voffA);
            PG8_BAR; PG8_WAIT_L(0); PG8_MMA(1, 0, At, B0); PG8_BAR; PG8_SCHED;
            PG8_STAGE(PG8_SB(1, 1), b3 + hstep, voffB);
            PG8_WAIT_V(6); PG8_BAR; PG8_MMA(1, 1, At, B1); PG8_BAR;
            }
        }
        if constexpr (ALIGN_EPI) { if (wr == 0) PG8_BAR; }
        if constexpr (!Epi::AFTER_DRAIN) { E(acc, cur, wr, wc, fr, fq, ui); S.done(cur); }
        if (!has_next) break;
#pragma unroll
        for (int a = 0; a < 2; ++a)
#pragma unroll
            for (int b = 0; b < 2; ++b)
#pragma unroll
                for (int m = 0; m < MT; ++m)
#pragma unroll
                    for (int n = 0; n < 2; ++n) acc[a][b][m][n] = (f32x4){0.f, 0.f, 0.f, 0.f};
        cur = nxt; cA = nA; cB = nB; ++ui;
        if constexpr (ALIGN_EPI) { if (wr == 1) PG8_BAR; }
    }
    PG8_WAIT_V(0);
    if constexpr (!ALIGN_EPI) { if (wr == 0) PG8_BAR; }
    PG8_BAR;
    if constexpr (Epi::AFTER_DRAIN) { E.fused(acc, cur, wr, wc, fr, fq, lds, wid, lane); S.done(cur); }
#undef PG8_SA
#undef PG8_SB
#undef PG8_STAGE
#undef PG8_LDA
#undef PG8_LDB
#undef PG8_MMA
#undef PG8_WAIT_V
#undef PG8_WAIT_L
#undef PG8_BAR
#undef PG8_SCHED
}
}
#define XB_TMO      128
#define XB_XCNT(j)  (256  + 64 * (j))
#define XB_XSUB(j)  (1280 + 64 * (j))
#define XB_XGEN(j)  (2304 + 64 * (j))
#define XB_TOP      3328
#define XB_TOPGEN   3392
#define XCD_BAR_WORDS 3456
#define XB_SPIN_CAP (1u << 18)

__device__ __forceinline__ unsigned xb_ld(unsigned* p)              { return __hip_atomic_load(p, __ATOMIC_RELAXED, __HIP_MEMORY_SCOPE_AGENT); }
__device__ __forceinline__ unsigned xb_add(unsigned* p, unsigned v) { return __hip_atomic_fetch_add(p, v, __ATOMIC_RELAXED, __HIP_MEMORY_SCOPE_AGENT); }
__device__ __forceinline__ unsigned xb_xcc_id() { return (unsigned)__builtin_amdgcn_s_getreg((3 << 11) | 20) & 0xFu; }
#define XB_SPIN(cond, bar) do { unsigned _sp = 0; while (cond) { __builtin_amdgcn_s_sleep(1); \
    if ((++_sp & 255u) == 0u) { if (xb_ld(&(bar)[XB_TMO])) break; if (_sp > XB_SPIN_CAP) { atomicAdd(&(bar)[XB_TMO], 1u); break; } } } } while (0)

struct XcdBarrier {
    unsigned* bar; unsigned x;
    volatile LAS unsigned* st;
};

__device__ __forceinline__ XcdBarrier xcd_barrier_post(unsigned* bar, volatile LAS unsigned* st) {
    XcdBarrier b; b.bar = bar; b.x = xb_xcc_id(); b.st = st;
    if (threadIdx.x == 0) (void)xb_add(&bar[XB_XCNT(b.x)], 1u);
    return b;
}
__device__ __forceinline__ void xcd_barrier_complete(unsigned* bar, unsigned x, unsigned& nloc, unsigned& nx) {
    const unsigned G = gridDim.x * gridDim.y * gridDim.z;
    unsigned sum, cnt, mine, sp = 0u;
    for (;;) {
        sum = 0u; cnt = 0u; mine = 0u;
#pragma unroll
        for (unsigned j = 0; j < 16; ++j) { const unsigned c = xb_ld(&bar[XB_XCNT(j)]); sum += c; cnt += (c > 0u) ? 1u : 0u; mine = (j == x) ? c : mine; }
        if (sum == G) break;
        __builtin_amdgcn_s_sleep(1);
        if ((++sp & 255u) == 0u) { if (xb_ld(&bar[XB_TMO])) break; if (sp > XB_SPIN_CAP) { atomicAdd(&bar[XB_TMO], 1u); break; } }
    }
    nloc = mine > 0u ? mine : 1u; nx = cnt > 0u ? cnt : 1u;
}

__device__ __forceinline__ void xcd_barrier(const XcdBarrier& b) {
    asm volatile("s_waitcnt vmcnt(0)" ::: "memory");
    __syncthreads();
    if (threadIdx.x == 0) {
        unsigned* bar = b.bar;
        __builtin_amdgcn_s_waitcnt(0);
        unsigned nloc = b.st[0], nx = b.st[1];
        if (nloc == 0u) { xcd_barrier_complete(bar, b.x, nloc, nx); b.st[0] = nloc; b.st[1] = nx; }
        const unsigned old = xb_add(&bar[XB_XSUB(b.x)], 1u);
        const unsigned gen = old / nloc;
        if (old + 1u == (gen + 1u) * nloc) {
            __builtin_amdgcn_fence(__ATOMIC_RELEASE, "agent");
            asm volatile("s_waitcnt vmcnt(0)" ::: "memory");
            const unsigned og = xb_add(&bar[XB_TOP], 1u);
            const unsigned tg = og / nx;
            if (og + 1u == (tg + 1u) * nx) xb_add(&bar[XB_TOPGEN], 1u);
            else XB_SPIN(xb_ld(&bar[XB_TOPGEN]) == tg, bar);
            __builtin_amdgcn_fence(__ATOMIC_ACQUIRE, "agent");
            xb_add(&bar[XB_XGEN(b.x)], 1u);
            asm volatile("s_waitcnt vmcnt(0)" ::: "memory");
        } else {
            XB_SPIN(xb_ld(&bar[XB_XGEN(b.x)]) == gen, bar);
            __builtin_amdgcn_fence(__ATOMIC_ACQUIRE, "agent");
            asm volatile("s_waitcnt vmcnt(0)" ::: "memory");
        }
    }
    __syncthreads();
}
__device__ __forceinline__ int cond_of_panel(int pm) { return pm < 16 ? 0 : 1 + ((pm - 16) >> 2); }
__device__ __forceinline__ f32x4 relu2(f32x4 v) { f32x4 r; r.x = fmaxf(v.x, 0.f); r.y = fmaxf(v.y, 0.f); r.z = fmaxf(v.z, 0.f); r.w = fmaxf(v.w, 0.f); return r * r; }
__device__ __forceinline__ float silu1(float x) { return x * __builtin_amdgcn_rcpf(1.f + __builtin_amdgcn_exp2f(-1.4426950408889634f * x)); }
__device__ __forceinline__ f32x4 silu4(f32x4 v) { f32x4 r; r.x = silu1(v.x); r.y = silu1(v.y); r.z = silu1(v.z); r.w = silu1(v.w); return r; }
__device__ __forceinline__ v4u pack8(f32x4 a, f32x4 b) { v4u w; w.x = cvtpk(a.x, a.y); w.y = cvtpk(a.z, a.w); w.z = cvtpk(b.x, b.y); w.w = cvtpk(b.z, b.w); return w; }
__device__ __forceinline__ f32x4 rope2(f32x4 v, f32x4 cs) { f32x4 r; r.x = v.x * cs.x - v.y * cs.y; r.y = v.y * cs.x + v.x * cs.y; r.z = v.z * cs.z - v.w * cs.w; r.w = v.w * cs.z + v.z * cs.w; return r; }

template <int MT> struct EpiQKV {
    static constexpr bool PERM = true, AFTER_DRAIN = false;
    const float* rowsq; const float* bias; const float* qnp; const float* taba;
    bf16* Q; bf16* KC; bf16* VC; bf16* KL; bf16* VL; float* nck; float* ncv; LAS float* xch;
    __device__ __forceinline__ void operator()(f32x4 (&acc)[2][2][MT][2], const pg8::Unit& u, int wr, int wc, int fr, int fq, int ui) const {
        const int pm = u.pm, pn = u.pn;
        const int rl0 = wr * (16 * MT) + fr, cw = wc * 32 + 8 * fq;
        {
            float rsv[2][MT];
#pragma unroll
            for (int ai = 0; ai < 2; ++ai)
#pragma unroll
                for (int m = 0; m < MT; ++m) rsv[ai][m] = rowsq[pm * (64 * MT) + rl0 + (32 * MT) * ai + 16 * m];
            f32x4 bv[2][2]; int cip = -1;
#pragma unroll
            for (int ai = 0; ai < 2; ++ai)
#pragma unroll
                for (int m = 0; m < MT; ++m) { const int row = pm * (64 * MT) + rl0 + (32 * MT) * ai + 16 * m; const int ci = __builtin_amdgcn_readfirstlane(row < M_CTX ? 0 : 1 + ((row - M_CTX) >> 10));
                    if (ci != cip) { cip = ci; const float* bp = bias + ci * NQKV + pn * 256 + cw;
#pragma unroll
                        for (int bj = 0; bj < 2; ++bj)
#pragma unroll
                            for (int n = 0; n < 2; ++n) bv[bj][n] = *(const f32x4*)(bp + bj * 128 + 4 * n); }
                    const float rs = rsqrtf(rsv[ai][m] * (1.f / DM) + EPS);
#pragma unroll
                    for (int bj = 0; bj < 2; ++bj)
#pragma unroll
                        for (int n = 0; n < 2; ++n) acc[ai][bj][m][n] = acc[ai][bj][m][n] * rs + bv[bj][n]; }
        }
        if (pn < 5) {
            LAS float* X = xch + (ui & 1) * 2048;
#pragma unroll
            for (int ai = 0; ai < 2; ++ai)
#pragma unroll
                for (int m = 0; m < MT; ++m)
#pragma unroll
                    for (int bj = 0; bj < 2; ++bj) { const f32x4 a = acc[ai][bj][m][0], b = acc[ai][bj][m][1];
                        float ss = (a.x * a.x + a.y * a.y) + (a.z * a.z + a.w * a.w) + (b.x * b.x + b.y * b.y) + (b.z * b.z + b.w * b.w);
                        ss += __shfl_xor(ss, 16); ss += __shfl_xor(ss, 32);
                        if (fq == 0) X[(rl0 + (32 * MT) * ai + 16 * m) * 8 + bj * 4 + wc] = ss; }
            f32x4 csv[2][MT][2];
#pragma unroll
            for (int ai = 0; ai < 2; ++ai)
#pragma unroll
                for (int m = 0; m < MT; ++m) { const int row = pm * (64 * MT) + rl0 + (32 * MT) * ai + 16 * m;
                    if (row >= M_CTX) { const float* t = taba + ((size_t)((row - M_CTX) & (S_LAT - 1)) * 64 + (cw >> 1)) * 2; csv[ai][m][0] = *(const f32x4*)t; csv[ai][m][1] = *(const f32x4*)(t + 4); } }
            LDS_WAIT(); __builtin_amdgcn_s_barrier(); asm volatile("" ::: "memory");
            const float* nw = qnp + (pn == 4 ? 128 : 0);
            const f32x4 w0 = *(const f32x4*)(nw + cw), w1 = *(const f32x4*)(nw + cw + 4);
#pragma unroll
            for (int ai = 0; ai < 2; ++ai)
#pragma unroll
                for (int m = 0; m < MT; ++m) {
                    const int rl = rl0 + (32 * MT) * ai + 16 * m, row = pm * (64 * MT) + rl; const bool lat = row >= M_CTX;
                    f32x4 cs0 = {1.f, 0.f, 1.f, 0.f}, cs1 = {1.f, 0.f, 1.f, 0.f}; int pos = 0, lb = 0;
                    if (lat) { pos = (row - M_CTX) & (S_LAT - 1); lb = (row - M_CTX) >> 10; cs0 = csv[ai][m][0]; cs1 = csv[ai][m][1]; }
#pragma unroll
                    for (int bj = 0; bj < 2; ++bj) {
                        const f32x4 p = *(const LAS f32x4*)(X + rl * 8 + bj * 4);
                        const float rn = rsqrtf(((p.x + p.y) + (p.z + p.w)) * (1.f / 128.f) + EPS);
                        f32x4 v0 = acc[ai][bj][m][0] * rn * w0, v1 = acc[ai][bj][m][1] * rn * w1;
                        if (lat) { v0 = rope2(v0, cs0); v1 = rope2(v1, cs1); }
                        const v4u w = pack8(v0, v1);
                        if (pn < 4) *(v4u*)(Q + (size_t)row * DM + pn * 256 + bj * 128 + cw) = w;
                        else if (!lat) {
                            *(v4u*)(KC + (size_t)row * 256 + bj * 128 + cw) = w;
                            const int q0 = cw >> 1, d0 = (q0 >> 5) * 64 + (q0 & 31);
                            float* o = nck + (size_t)row * 256 + bj * 128 + d0;
                            *(f32x4*)o = (f32x4){v0.x, v0.z, v1.x, v1.z}; *(f32x4*)(o + 32) = (f32x4){v0.y, v0.w, v1.y, v1.w};
                        } else *(v4u*)(KL + ((size_t)lb * KVL + PAST + pos) * 256 + bj * 128 + cw) = w;
                    }
                }
        } else {
#pragma unroll
            for (int ai = 0; ai < 2; ++ai)
#pragma unroll
                for (int m = 0; m < MT; ++m) {
                    const int row = pm * (64 * MT) + rl0 + (32 * MT) * ai + 16 * m; const bool lat = row >= M_CTX;
#pragma unroll
                    for (int bj = 0; bj < 2; ++bj) {
                        const f32x4 v0 = acc[ai][bj][m][0], v1 = acc[ai][bj][m][1]; const v4u w = pack8(v0, v1);
                        if (!lat) { *(v4u*)(VC + (size_t)row * 256 + bj * 128 + cw) = w; float* o = ncv + (size_t)row * 256 + bj * 128 + cw; *(f32x4*)o = v0; *(f32x4*)(o + 4) = v1; }
                        else { const int pos = (row - M_CTX) & (S_LAT - 1), lb = (row - M_CTX) >> 10; *(v4u*)(VL + ((size_t)lb * KVL + PAST + pos) * 256 + bj * 128 + cw) = w; }
                    }
                }
        }
    }
};

template <int MT> struct EpiRes {
    static constexpr bool PERM = true, AFTER_DRAIN = false;
    bf16* ab; const float* gs_old;
    const float* gate; const float* gs_new; float* rsq;
    __device__ __forceinline__ void operator()(f32x4 (&acc)[2][2][MT][2], const pg8::Unit& u, int wr, int wc, int fr, int fq, int ui) const {
        const int pm = u.pm, pn = u.pn;
        const int rl0 = wr * (16 * MT) + fr, col0 = pn * 256 + wc * 32 + 8 * fq;
        v4u ao[2][MT][2];
#pragma unroll
        for (int ai = 0; ai < 2; ++ai)
#pragma unroll
            for (int m = 0; m < MT; ++m) { const int row = pm * (64 * MT) + rl0 + (32 * MT) * ai + 16 * m;
#pragma unroll
                for (int bj = 0; bj < 2; ++bj) ao[ai][m][bj] = *(const v4u*)(ab + (size_t)row * DM + col0 + bj * 128); }
        f32x4 gv[2][2], go[2][2], gn[2][2]; int cip = -1;
#pragma unroll
        for (int ai = 0; ai < 2; ++ai)
#pragma unroll
            for (int m = 0; m < MT; ++m) {
                const int row = pm * (64 * MT) + rl0 + (32 * MT) * ai + 16 * m;
                const int ci = __builtin_amdgcn_readfirstlane(row < M_CTX ? 0 : 1 + ((row - M_CTX) >> 10));
                if (ci != cip) { cip = ci;
#pragma unroll
                    for (int bj = 0; bj < 2; ++bj)
#pragma unroll
                        for (int n = 0; n < 2; ++n) { gv[bj][n] = *(const f32x4*)(gate + ci * 6144 + col0 + bj * 128 + 4 * n); go[bj][n] = *(const f32x4*)(gs_old + ci * DM + col0 + bj * 128 + 4 * n); gn[bj][n] = *(const f32x4*)(gs_new + ci * DM + col0 + bj * 128 + 4 * n); } }
                float ss = 0.f;
#pragma unroll
                for (int bj = 0; bj < 2; ++bj) {
                    const v4u w = ao[ai][m][bj];
                    const f32x4 x0 = (f32x4){__builtin_bit_cast(float, w.x << 16), __builtin_bit_cast(float, w.x & 0xffff0000u), __builtin_bit_cast(float, w.y << 16), __builtin_bit_cast(float, w.y & 0xffff0000u)} / go[bj][0];
                    const f32x4 x1 = (f32x4){__builtin_bit_cast(float, w.z << 16), __builtin_bit_cast(float, w.z & 0xffff0000u), __builtin_bit_cast(float, w.w << 16), __builtin_bit_cast(float, w.w & 0xffff0000u)} / go[bj][1];
                    const f32x4 y0 = x0 + gv[bj][0] * acc[ai][bj][m][0], y1 = x1 + gv[bj][1] * acc[ai][bj][m][1];
                    ss += (y0.x * y0.x + y0.y * y0.y) + (y0.z * y0.z + y0.w * y0.w) + (y1.x * y1.x + y1.y * y1.y) + (y1.z * y1.z + y1.w * y1.w);
                    *(v4u*)(ab + (size_t)row * DM + col0 + bj * 128) = pack8(y0 * gn[bj][0], y1 * gn[bj][1]);
                }
                ss += __shfl_xor(ss, 16); ss += __shfl_xor(ss, 32);
                if (fq == 0) atomicAdd(rsq + row, ss);
            }
    }
};

struct EpiResFinal {
    static constexpr bool PERM = true, AFTER_DRAIN = false;
    const bf16* ab; const float* gs_old; float* yout; const float* gate; const float* fg; float* rsq; unsigned* cnt;
    __device__ __forceinline__ void operator()(f32x4 (&acc)[2][2][3][2], const pg8::Unit& u, int wr, int wc, int fr, int fq, int ui) const {
        constexpr int MT = 3;
        const int pm = u.pm, pn = u.pn;
        const int rl0 = wr * (16 * MT) + fr, col0 = pn * 256 + wc * 32 + 8 * fq;
        v4u ao[2][MT][2];
#pragma unroll
        for (int ai = 0; ai < 2; ++ai)
#pragma unroll
            for (int m = 0; m < MT; ++m) { const int row = pm * (64 * MT) + rl0 + (32 * MT) * ai + 16 * m;
#pragma unroll
                for (int bj = 0; bj < 2; ++bj) ao[ai][m][bj] = *(const v4u*)(ab + (size_t)row * DM + col0 + bj * 128); }
        f32x4 gv[2][2], go[2][2]; int cip = -1;
#pragma unroll
        for (int ai = 0; ai < 2; ++ai)
#pragma unroll
            for (int m = 0; m < MT; ++m) {
                const int row = pm * (64 * MT) + rl0 + (32 * MT) * ai + 16 * m;
                const int ci = __builtin_amdgcn_readfirstlane(row < M_CTX ? 0 : 1 + ((row - M_CTX) >> 10));
                if (ci != cip) { cip = ci;
#pragma unroll
                    for (int bj = 0; bj < 2; ++bj)
#pragma unroll
                        for (int n = 0; n < 2; ++n) { gv[bj][n] = *(const f32x4*)(gate + ci * 6144 + col0 + bj * 128 + 4 * n); go[bj][n] = *(const f32x4*)(gs_old + ci * DM + col0 + bj * 128 + 4 * n); } }
                float ss = 0.f;
#pragma unroll
                for (int bj = 0; bj < 2; ++bj) {
                    const v4u w = ao[ai][m][bj];
                    const f32x4 x0 = (f32x4){__builtin_bit_cast(float, w.x << 16), __builtin_bit_cast(float, w.x & 0xffff0000u), __builtin_bit_cast(float, w.y << 16), __builtin_bit_cast(float, w.y & 0xffff0000u)} / go[bj][0];
                    const f32x4 x1 = (f32x4){__builtin_bit_cast(float, w.z << 16), __builtin_bit_cast(float, w.z & 0xffff0000u), __builtin_bit_cast(float, w.w << 16), __builtin_bit_cast(float, w.w & 0xffff0000u)} / go[bj][1];
                    const f32x4 y0 = x0 + gv[bj][0] * acc[ai][bj][m][0], y1 = x1 + gv[bj][1] * acc[ai][bj][m][1];
                    ss += (y0.x * y0.x + y0.y * y0.y) + (y0.z * y0.z + y0.w * y0.w) + (y1.x * y1.x + y1.y * y1.y) + (y1.z * y1.z + y1.w * y1.w);
                    acc[ai][bj][m][0] = y0; acc[ai][bj][m][1] = y1;
                }
                ss += __shfl_xor(ss, 16); ss += __shfl_xor(ss, 32);
                if (fq == 0) atomicAdd(rsq + row, ss);
            }
        asm volatile("s_waitcnt vmcnt(0)" ::: "memory");
        unsigned* c = cnt + 64 * pm;
        if ((threadIdx.x & 63) == 0) __hip_atomic_fetch_add(c, 1u, __ATOMIC_RELAXED, __HIP_MEMORY_SCOPE_AGENT);
        if (threadIdx.x < 64) { unsigned sp = 0;
            while ((unsigned)__builtin_amdgcn_readfirstlane(__hip_atomic_load(c, __ATOMIC_RELAXED, __HIP_MEMORY_SCOPE_AGENT)) < 32u) { __builtin_amdgcn_s_sleep(2); if (++sp > (1u << 22)) break; } }
        asm volatile("s_waitcnt vmcnt(0) lgkmcnt(0)" ::: "memory"); __builtin_amdgcn_s_barrier(); asm volatile("" ::: "memory");
        f32x4 fgv[2][2]; float rq[2][MT];
#pragma unroll
        for (int bj = 0; bj < 2; ++bj)
#pragma unroll
            for (int n = 0; n < 2; ++n) fgv[bj][n] = *(const f32x4*)(fg + col0 + bj * 128 + 4 * n);
#pragma unroll
        for (int ai = 0; ai < 2; ++ai)
#pragma unroll
            for (int m = 0; m < MT; ++m) rq[ai][m] = __hip_atomic_load(rsq + pm * (64 * MT) + rl0 + (32 * MT) * ai + 16 * m, __ATOMIC_RELAXED, __HIP_MEMORY_SCOPE_AGENT);
#pragma unroll
        for (int ai = 0; ai < 2; ++ai)
#pragma unroll
            for (int m = 0; m < MT; ++m) {
                const int row = pm * (64 * MT) + rl0 + (32 * MT) * ai + 16 * m;
                const float rs = rsqrtf(rq[ai][m] * (1.f / DM) + EPS);
#pragma unroll
                for (int bj = 0; bj < 2; ++bj) { float* o = yout + (size_t)row * DM + col0 + bj * 128; *(f32x4*)o = acc[ai][bj][m][0] * rs * fgv[bj][0]; *(f32x4*)(o + 4) = acc[ai][bj][m][1] * rs * fgv[bj][1]; }
            }
    }
};

struct EpiMlp1 {
    static constexpr bool PERM = true, AFTER_DRAIN = false;
    const float* rowsq; const float* bias; bf16* H;
#ifdef TS_LO
    unsigned long long* tsb;
#endif
    __device__ __forceinline__ void operator()(f32x4 (&acc)[2][2][4][2], const pg8::Unit& u, int wr, int wc, int fr, int fq, int ui) const {
#ifdef TS_LO
        if (tsb && blockIdx.x == 0 && threadIdx.x == 0) tsb[16 + 2 * ui] = __builtin_amdgcn_s_memrealtime();
#endif
        const int pm = u.pm, pn = u.pn; const int ci = cond_of_panel(pm);
        const int rl0 = wr * 64 + fr, col0 = pn * 256 + wc * 32 + 8 * fq;
        f32x4 bv[2][2];
#pragma unroll
        for (int bj = 0; bj < 2; ++bj)
#pragma unroll
            for (int n = 0; n < 2; ++n) bv[bj][n] = *(const f32x4*)(bias + ci * FFD + col0 + bj * 128 + 4 * n);
        float rsv[2][4];
#pragma unroll
        for (int ai = 0; ai < 2; ++ai)
#pragma unroll
            for (int m = 0; m < 4; ++m) rsv[ai][m] = rowsq[pm * 256 + rl0 + 128 * ai + 16 * m];
#pragma unroll
        for (int ai = 0; ai < 2; ++ai)
#pragma unroll
            for (int m = 0; m < 4; ++m) {
                const int row = pm * 256 + rl0 + 128 * ai + 16 * m; const float rs = rsqrtf(rsv[ai][m] * (1.f / DM) + EPS);
#pragma unroll
                for (int bj = 0; bj < 2; ++bj)
                    *(v4u*)(H + (size_t)row * FFD + col0 + bj * 128) = pack8(relu2(acc[ai][bj][m][0] * rs + bv[bj][0]), relu2(acc[ai][bj][m][1] * rs + bv[bj][1]));
            }
#ifdef TS_LO
        if (tsb && blockIdx.x == 0 && threadIdx.x == 0) tsb[17 + 2 * ui] = __builtin_amdgcn_s_memrealtime();
#endif
    }
};

struct EpiProj {
    static constexpr bool PERM = true, AFTER_DRAIN = false;
    const float* rowsq; const float* bias; const float* tabr; bf16* RQ; bf16* RK; bf16* RV; bf16* RG;
    __device__ __forceinline__ void operator()(f32x4 (&acc)[2][2][4][2], const pg8::Unit& u, int wr, int wc, int fr, int fq, int ui) const {
        const int pm = u.pm, pn = u.pn; const bool lat = pm >= 16; const int ci = cond_of_panel(pm);
        const int rl0 = wr * 64 + fr, cw = wc * 32 + 8 * fq;
        f32x4 bv[2][2];
#pragma unroll
        for (int bj = 0; bj < 2; ++bj)
#pragma unroll
            for (int n = 0; n < 2; ++n) bv[bj][n] = *(const f32x4*)(bias + ci * NRETP + pn * 256 + bj * 128 + cw + 4 * n);
        bf16* dst = RQ + (size_t)(pn >> 2) * ((size_t)MTOK * DM) + (pn & 3) * 256 + cw;
        const float qs = pn < 4 ? 0.0625f : 1.f;
        float rsv[2][4];
#pragma unroll
        for (int ai = 0; ai < 2; ++ai)
#pragma unroll
            for (int m = 0; m < 4; ++m) rsv[ai][m] = rowsq[pm * 256 + rl0 + 128 * ai + 16 * m];
        const bool rope = pn < 8 && lat;
        f32x4 csr[2][2], cca[2], ccb[2];
        const float* tcol = tabr + ((size_t)fr * 128 + 64 + (cw >> 1)) * 2;
        if (rope) {
            const int pbase = (pm * 256 - M_CTX) & (S_LAT - 1);
#pragma unroll
            for (int ai = 0; ai < 2; ++ai) { const float* t = tabr + ((size_t)(pbase + 128 * ai + 64 * wr) * 128 + (cw >> 1)) * 2; csr[ai][0] = *(const f32x4*)t; csr[ai][1] = *(const f32x4*)(t + 4); }
            cca[0] = *(const f32x4*)tcol; cca[1] = *(const f32x4*)(tcol + 4);
        }
#define PROJ_FRAG(m, CC) do { _Pragma("unroll") for (int ai = 0; ai < 2; ++ai) { \
            const int row = pm * 256 + rl0 + 128 * ai + 16 * (m); const float rs = rsqrtf(rsv[ai][m] * (1.f / DM) + EPS); \
            _Pragma("unroll") for (int bj = 0; bj < 2; ++bj) { \
                f32x4 v0 = acc[ai][bj][m][0] * rs + bv[bj][0], v1 = acc[ai][bj][m][1] * rs + bv[bj][1]; \
                if (pn < 8) { if (lat) { v0 = rope2(v0, bj ? CC[0] : csr[ai][0]); v1 = rope2(v1, bj ? CC[1] : csr[ai][1]); } v0 = v0 * qs; v1 = v1 * qs; } \
                else if (pn >= 12) { v0 = silu4(v0); v1 = silu4(v1); } \
                *(v4u*)(dst + (size_t)row * DM + bj * 128) = pack8(v0, v1); } } } while (0)
#define PROJ_NEXT(m, CC) do { if (rope) { CC[0] = *(const f32x4*)(tcol + (size_t)(16 * (m)) * 256); CC[1] = *(const f32x4*)(tcol + (size_t)(16 * (m)) * 256 + 4); } } while (0)
        PROJ_NEXT(1, ccb); PROJ_FRAG(0, cca);
        PROJ_NEXT(2, cca); PROJ_FRAG(1, ccb);
        PROJ_NEXT(3, ccb); PROJ_FRAG(2, cca);
        PROJ_FRAG(3, ccb);
#undef PROJ_FRAG
#undef PROJ_NEXT
    }
};
__device__ __forceinline__ float wave_sum(float v) {
#pragma unroll
    for (int o = 1; o < 64; o <<= 1) v += __shfl_xor(v, o);
    return v;
}
template <int MAP> __device__ __forceinline__ int rowmap(int n) {
    if (MAP == 1) return n < 1280 ? (n & ~127) + posA(n & 127) : n;
    if (MAP == 2) return n < 2048 ? (n & ~255) + posR(n & 255) : n;
    return n;
}
template <int MAP, bool BIAS = false> __device__ __forceinline__ void p0_transpose_item(const float* W, int K, int N, bf16* WT, LAS float* scr, int item, int lane, const float* sh = nullptr, float* bout = nullptr, LAS float* shs = nullptr) {
    const int nblk = N / 64, kb = item / nblk, nb = item % nblk, k0 = 64 * kb, n0 = 64 * nb;
    const int kr = lane >> 4, ng = lane & 15;
    f32x4 w[16];
    const float* wp = W + (size_t)(k0 + kr) * N + n0 + 4 * ng;
#pragma unroll
    for (int i = 0; i < 16; ++i) w[i] = *(const f32x4*)(wp + (size_t)(4 * i) * N);
#pragma unroll
    for (int i = 0; i < 16; ++i) { const int k = 4 * i + kr; *(LAS f32x4*)(scr + k * 64 + 4 * (ng ^ (k >> 3))) = w[i]; }
    LDS_WAIT(); asm volatile("" ::: "memory");
#pragma unroll
    for (int it = 0; it < 8; ++it) { const int nn = it * 8 + (lane >> 3), c = lane & 7; const LAS float* s = scr + (8 * c) * 64 + 4 * ((nn >> 2) ^ c) + (nn & 3);
        v4u o; o.x = pk2(s[0 * 64], s[1 * 64]); o.y = pk2(s[2 * 64], s[3 * 64]); o.z = pk2(s[4 * 64], s[5 * 64]); o.w = pk2(s[6 * 64], s[7 * 64]);
        *(GAS v4u*)(WT + (size_t)rowmap<MAP>(n0 + nn) * K + k0 + 8 * c) = o; }
    if (BIAS) {
        LAS float* ssh = shs;
#pragma unroll
        for (int ci = 0; ci < NCOND; ++ci) ssh[ci * 64 + lane] = sh[ci * 6144 + k0 + lane];
        LDS_WAIT(); asm volatile("" ::: "memory");
        float b[NCOND];
#pragma unroll
        for (int ci = 0; ci < NCOND; ++ci) b[ci] = 0.f;
#pragma unroll 2
        for (int k = 0; k < 64; k += 4) {
            float w[4];
#pragma unroll
            for (int j = 0; j < 4; ++j) w[j] = scr[(k + j) * 64 + 4 * ((lane >> 2) ^ ((k + j) >> 3)) + (lane & 3)];
#pragma unroll
            for (int ci = 0; ci < NCOND; ++ci) { const f32x4 sv = *(const LAS f32x4*)(ssh + ci * 64 + k); b[ci] += sv.x * w[0] + sv.y * w[1] + sv.z * w[2] + sv.w * w[3]; }
        }
        const int col = rowmap<MAP>(n0 + lane);
#pragma unroll
        for (int ci = 0; ci < NCOND; ++ci) atomicAdd(bout + (size_t)ci * N + col, b[ci]);
    }
    LDS_WAIT(); asm volatile("" ::: "memory");
}
__device__ __forceinline__ void p0_mod_item(const float* W, int n0, int k0, const float* c_ctx, const float* c_lat, float* out, const float* addb, LAS float* scr, int lane, unsigned long long* tsx = nullptr) {
    constexpr int N = 6144;
#pragma unroll
    for (int ci = 0; ci < NCOND; ++ci) { const float x = (ci == 0 ? c_ctx : c_lat + (ci - 1) * DM)[k0 + lane]; scr[ci * 64 + lane] = x / (1.f + expf(-x)); }
    LDS_WAIT(); asm volatile("" ::: "memory");
    if (tsx && lane == 0) atomicMax(tsx + 44, (unsigned long long)__builtin_amdgcn_s_memrealtime());
    f32x4 a[NCOND];
#pragma unroll
    for (int ci = 0; ci < NCOND; ++ci) a[ci] = (f32x4){0.f, 0.f, 0.f, 0.f};
    const float* wp = W + (size_t)k0 * N + n0 + 4 * lane;
#pragma unroll 1
    for (int kk = 0; kk < 64; kk += 32) {
        f32x4 w[32];
#pragma unroll
        for (int j = 0; j < 32; ++j) w[j] = *(const f32x4*)(wp + (size_t)(kk + j) * N);
#pragma unroll
        for (int j4 = 0; j4 < 8; ++j4)
#pragma unroll
            for (int ci = 0; ci < NCOND; ++ci) { const f32x4 s = *(const LAS f32x4*)(scr + ci * 64 + kk + 4 * j4);
                a[ci] = a[ci] + w[4 * j4] * s.x + w[4 * j4 + 1] * s.y + w[4 * j4 + 2] * s.z + w[4 * j4 + 3] * s.w; }
    }
    if (tsx && lane == 0) atomicMax(tsx + 45, (unsigned long long)__builtin_amdgcn_s_memrealtime());
    LAS float* tr = scr + 1024;
#pragma unroll
    for (int ci = 0; ci < NCOND; ++ci) { f32x4 r = a[ci]; if (k0 == 0) r = r + *(const f32x4*)(addb + n0 + 4 * lane); *(LAS f32x4*)(tr + ci * 256 + 4 * lane) = r; }
    LDS_WAIT(); asm volatile("" ::: "memory");
#pragma unroll
    for (int ci = 0; ci < NCOND; ++ci)
#pragma unroll
        for (int j = 0; j < 4; ++j) atomicAdd(out + (size_t)ci * N + n0 + 64 * j + lane, tr[ci * 256 + 64 * j + lane]);
    LDS_WAIT(); asm volatile("" ::: "memory");
}
__device__ __forceinline__ void p1_bias_item(const bf16* WT, int n0, const float* sh, float* out, int ostride, int lane) {
    v4u w[4][2];
#pragma unroll
    for (int r = 0; r < 4; ++r)
#pragma unroll
        for (int h = 0; h < 2; ++h) w[r][h] = *(const v4u*)(WT + (size_t)(n0 + r) * DM + 512 * h + 8 * lane);
    float acc[4][NCOND];
#pragma unroll
    for (int r = 0; r < 4; ++r)
#pragma unroll
        for (int ci = 0; ci < NCOND; ++ci) acc[r][ci] = 0.f;
#pragma unroll
    for (int h = 0; h < 2; ++h)
#pragma unroll
        for (int ci = 0; ci < NCOND; ++ci) {
            const f32x4 s0 = *(const f32x4*)(sh + (size_t)ci * 6144 + 512 * h + 8 * lane), s1 = *(const f32x4*)(sh + (size_t)ci * 6144 + 512 * h + 8 * lane + 4);
#pragma unroll
            for (int r = 0; r < 4; ++r) { const v4u u = w[r][h];
                acc[r][ci] += __builtin_bit_cast(float, u.x << 16) * s0.x + __builtin_bit_cast(float, u.x & 0xffff0000u) * s0.y + __builtin_bit_cast(float, u.y << 16) * s0.z + __builtin_bit_cast(float, u.y & 0xffff0000u) * s0.w
                            + __builtin_bit_cast(float, u.z << 16) * s1.x + __builtin_bit_cast(float, u.z & 0xffff0000u) * s1.y + __builtin_bit_cast(float, u.w << 16) * s1.z + __builtin_bit_cast(float, u.w & 0xffff0000u) * s1.w; }
        }
#pragma unroll
    for (int r = 0; r < 4; ++r)
#pragma unroll
        for (int ci = 0; ci < NCOND; ++ci) { const float v = wave_sum(acc[r][ci]); if (lane == r * NCOND + ci) out[(size_t)ci * ostride + n0 + r] = v; }
}
namespace att {
constexpr int D = 128, NW = 8, QBLK = 32, KVBLK = 64;
constexpr float SCALE = 0.088388347648318440f;
constexpr float THR = 8.f;
constexpr int LDQ = 1024, LDK = 256, LDO = 1024;
constexpr size_t SHM_V = KVBLK * D * 2, SHM_K = KVBLK * D * 2, SHM_ATTN = 2 * SHM_V + 2 * SHM_K + NW * 64 * 4;
#define KSWZ(row, colB) ((row) * 256 + ((colB) ^ (((row) & 7) << 4)))
#define SBAR() __builtin_amdgcn_sched_barrier(0)
__device__ __forceinline__ int crow(int r, int hi) { return (r & 3) + 8 * (r >> 2) + 4 * hi; }
__device__ __forceinline__ void partialSM(f32x16& p0, f32x16& p1, float& m_reg, float& mn, float& alpha) {
  constexpr float C = SCALE * 1.4426950408889634f;
  float pmax = p0[0]; for (int r = 1; r < 16; ++r) pmax = fmaxf(pmax, p0[r]); for (int r = 0; r < 16; ++r) pmax = fmaxf(pmax, p1[r]);
  { auto rr = __builtin_amdgcn_permlane32_swap(__float_as_uint(pmax), __float_as_uint(pmax), false, false);
    pmax = fmaxf(__uint_as_float(rr[0]), __uint_as_float(rr[1])); }
  if (__builtin_expect(__all(pmax - m_reg <= THR / SCALE), 1)) { mn = m_reg; alpha = 1.f; }
  else { mn = fmaxf(m_reg, pmax); alpha = __builtin_amdgcn_exp2f((m_reg - mn) * C); m_reg = mn; }
  float mnC = -mn * C;
  for (int r = 0; r < 16; ++r) p0[r] = fmaf(p0[r], C, mnC); for (int r = 0; r < 16; ++r) p1[r] = fmaf(p1[r], C, mnC);
  for (int r = 0; r < 16; ++r) p0[r] = __builtin_amdgcn_exp2f(p0[r]);
}
__device__ __forceinline__ void finishSM(f32x16& p0, f32x16& p1, float alpha, float& l_reg, bf16x8& pa0, bf16x8& pa1, bf16x8& pa2, bf16x8& pa3) {
  for (int r = 0; r < 16; ++r) p1[r] = __builtin_amdgcn_exp2f(p1[r]);
  float ps = 0; for (int r = 0; r < 16; ++r) ps += p0[r]; for (int r = 0; r < 16; ++r) ps += p1[r];
  { auto rr = __builtin_amdgcn_permlane32_swap(__float_as_uint(ps), __float_as_uint(ps), false, false);
    ps = __uint_as_float(rr[0]) + __uint_as_float(rr[1]); }
  l_reg = l_reg * alpha + ps;
#define PK4(P, BASE, OUT) do { unsigned a0 = cvtpk(P[BASE + 0], P[BASE + 1]), a1 = cvtpk(P[BASE + 2], P[BASE + 3]);   \
    unsigned b0 = cvtpk(P[BASE + 4], P[BASE + 5]), b1 = cvtpk(P[BASE + 6], P[BASE + 7]);                              \
    auto r0 = __builtin_amdgcn_permlane32_swap(a0, b0, false, false); auto r1 = __builtin_amdgcn_permlane32_swap(a1, b1, false, false); \
    v4u w = {r0[0], r1[0], r0[1], r1[1]}; OUT = *reinterpret_cast<bf16x8*>(&w); } while (0)
  PK4(p0, 0, pa0); PK4(p0, 8, pa1); PK4(p1, 0, pa2); PK4(p1, 8, pa3);
#undef PK4
}
__device__ __forceinline__ void qkt(f32x16& p0, f32x16& p1, const bf16* Ks, const bf16x8* qr, int r32, int hi) {
  p0 = f32x16{}; p1 = f32x16{};
  for (int d0 = 0; d0 < 8; ++d0) { int cb = (d0 * 16 + hi * 8) * 2;
    bf16x8 b0 = *reinterpret_cast<const bf16x8*>((const char*)Ks + KSWZ(r32, cb));
    bf16x8 b1 = *reinterpret_cast<const bf16x8*>((const char*)Ks + KSWZ(32 + r32, cb));
    p0 = __builtin_amdgcn_mfma_f32_32x32x16_bf16(b0, qr[d0], p0, 0, 0, 0);
    p1 = __builtin_amdgcn_mfma_f32_32x32x16_bf16(b1, qr[d0], p1, 0, 0, 0); }
}
__device__ __forceinline__ int v_st(int k, int c) { const int kk = (k & ~0xC) | ((k & 4) << 1) | ((k & 8) >> 1); return ((kk >> 3) * 4 + (c >> 5)) * 512 + ((kk & 7) * 32 + (c & 31)) * 2; }
__device__ __forceinline__ int v_rd_base(int lane) { return ((lane & 3) << 3) | (((lane >> 2) & 3) << 6) | (((lane >> 4) & 1) << 5) | (((lane >> 5) & 1) << 8); }
constexpr int v_rd_off(int d0, int ks, int half) { return d0 * 512 + ks * 4096 + half * 2048; }
template <int OFF> __device__ __forceinline__ s16x4 tr_read(int vb) {
  s16x4 r; asm volatile("ds_read_b64_tr_b16 %0, %1 offset:%2" : "=&v"(r) : "v"(vb), "i"(OFF) : "memory"); return r;
}
#define ATT_PK(L, H) (bf16x8){L[0], L[1], L[2], L[3], H[0], H[1], H[2], H[3]}
template <int D0> __device__ __forceinline__ void pv_one(f32x16& od, int vb, bf16x8 pa0, bf16x8 pa1, bf16x8 pa2, bf16x8 pa3) {
  const s16x4 l0 = tr_read<v_rd_off(D0, 0, 0)>(vb), h0 = tr_read<v_rd_off(D0, 0, 1)>(vb), l1 = tr_read<v_rd_off(D0, 1, 0)>(vb), h1 = tr_read<v_rd_off(D0, 1, 1)>(vb);
  const s16x4 l2 = tr_read<v_rd_off(D0, 2, 0)>(vb), h2 = tr_read<v_rd_off(D0, 2, 1)>(vb), l3 = tr_read<v_rd_off(D0, 3, 0)>(vb), h3 = tr_read<v_rd_off(D0, 3, 1)>(vb);
  asm volatile("s_waitcnt lgkmcnt(0)" ::: "memory"); SBAR();
  od = __builtin_amdgcn_mfma_f32_32x32x16_bf16(pa0, ATT_PK(l0, h0), od, 0, 0, 0);
  od = __builtin_amdgcn_mfma_f32_32x32x16_bf16(pa1, ATT_PK(l1, h1), od, 0, 0, 0);
  od = __builtin_amdgcn_mfma_f32_32x32x16_bf16(pa2, ATT_PK(l2, h2), od, 0, 0, 0);
  od = __builtin_amdgcn_mfma_f32_32x32x16_bf16(pa3, ATT_PK(l3, h3), od, 0, 0, 0);
}
__device__ __forceinline__ void pv_d0(f32x16* o, int vb, bf16x8 pa0, bf16x8 pa1, bf16x8 pa2, bf16x8 pa3) {
  pv_one<0>(o[0], vb, pa0, pa1, pa2, pa3); pv_one<1>(o[1], vb, pa0, pa1, pa2, pa3); pv_one<2>(o[2], vb, pa0, pa1, pa2, pa3); pv_one<3>(o[3], vb, pa0, pa1, pa2, pa3);
}
__device__ __forceinline__ void attn_unit(const bf16* Qb, const bf16* __restrict__ Kh, const bf16* __restrict__ Vh, bf16* Ob, int seq, char* lds) {
  const int tid = threadIdx.x, wid = tid >> 6, lane = tid & 63, r32 = lane & 31, hi = lane >> 5;
  bf16* V_lds = (bf16*)lds; bf16* K_lds = (bf16*)(lds + 2 * SHM_V);
  float* ws = (float*)(lds + 2 * SHM_V + 2 * SHM_K) + wid * 64; float* li_l = ws; float* al_l = ws + 32;
  float m_reg = -1e30f, l_reg = 0; f32x16 o[4] = {}; bf16x8 qr[8];
  const bf16* Qw = Qb + (long)(wid * QBLK + r32) * LDQ + hi * 8;
#pragma unroll
  for (int d0 = 0; d0 < 8; ++d0) qr[d0] = *reinterpret_cast<const bf16x8*>(Qw + d0 * 16);
  const int sr = tid >> 4, sc = (tid & 15) * 8, vst0 = v_st(sr, sc), vst1 = v_st(32 + sr, sc);
  const int vb0 = (int)(uintptr_t)V_lds + v_rd_base(lane);
  struct { bf16x8 vs0, vs1, ks0, ks1; } sr_[2];
#define SLOAD(i, k0) do { sr_[i].vs0 = *reinterpret_cast<const bf16x8*>(&Vh[(long)((k0) + sr) * LDK + sc]); sr_[i].vs1 = *reinterpret_cast<const bf16x8*>(&Vh[(long)((k0) + 32 + sr) * LDK + sc]); \
    sr_[i].ks0 = *reinterpret_cast<const bf16x8*>(&Kh[(long)((k0) + sr) * LDK + sc]); sr_[i].ks1 = *reinterpret_cast<const bf16x8*>(&Kh[(long)((k0) + 32 + sr) * LDK + sc]); } while (0)
#define SWRITE(b, i) do { *(bf16x8*)((char*)V_lds + (b) * SHM_V + vst0) = sr_[i].vs0;          \
    *(bf16x8*)((char*)V_lds + (b) * SHM_V + vst1) = sr_[i].vs1; int kc = sc * 2;               \
    *(bf16x8*)((char*)K_lds + (b) * SHM_K + KSWZ(sr, kc)) = sr_[i].ks0;                       \
    *(bf16x8*)((char*)K_lds + (b) * SHM_K + KSWZ(32 + sr, kc)) = sr_[i].ks1; } while (0)
#define SWAIT() asm volatile("s_waitcnt vmcnt(4)" ::: "memory")
#define RESC(a) do { if (__any((a) < 1.f)) { if (hi == 0) al_l[r32] = (a); asm volatile("s_waitcnt lgkmcnt(0)" ::: "memory"); \
    for (int d = 0; d < 4; ++d) for (int r = 0; r < 16; ++r) o[d][r] *= al_l[crow(r, hi)]; } } while (0)
  f32x16 pA0, pA1, pB0, pB1; float mnA, mnB, alA, alB; bf16x8 pa0, pa1, pa2, pa3; const int NT = seq / KVBLK;
  constexpr int SE = 0, SO = 1;
  SLOAD(SE, 0); SLOAD(SO, KVBLK);
  SWAIT(); SWRITE(0, SE); __syncthreads();
  qkt(pA0, pA1, K_lds, qr, r32, hi); partialSM(pA0, pA1, m_reg, mnA, alA);
  if (2 < NT) SLOAD(SE, 2 * KVBLK);
  if (2 < NT) SWAIT(); else asm volatile("s_waitcnt vmcnt(0)" ::: "memory");
  SWRITE(1, SO); __syncthreads();
  for (int j = 1; j + 1 < NT; j += 2) {
    SBAR(); qkt(pB0, pB1, (bf16*)((char*)K_lds + SHM_K), qr, r32, hi);
    finishSM(pA0, pA1, alA, l_reg, pa0, pa1, pa2, pa3); SBAR();
    SLOAD(SO, (j + 2) * KVBLK); SBAR();
    pv_d0(o, vb0, pa0, pa1, pa2, pa3); partialSM(pB0, pB1, m_reg, mnB, alB);
    __syncthreads(); SWAIT(); SWRITE(0, SE);
    RESC(alB); __syncthreads();
    SBAR(); qkt(pA0, pA1, K_lds, qr, r32, hi);
    finishSM(pB0, pB1, alB, l_reg, pa0, pa1, pa2, pa3); SBAR();
    if (j + 3 < NT) SLOAD(SE, (j + 3) * KVBLK); SBAR();
    pv_d0(o, vb0 + (int)SHM_V, pa0, pa1, pa2, pa3); partialSM(pA0, pA1, m_reg, mnA, alA);
    __syncthreads(); SWAIT(); SWRITE(1, SO);
    RESC(alA); __syncthreads();
  }
  SBAR(); qkt(pB0, pB1, (bf16*)((char*)K_lds + SHM_K), qr, r32, hi);
  finishSM(pA0, pA1, alA, l_reg, pa0, pa1, pa2, pa3); SBAR();
  pv_d0(o, vb0, pa0, pa1, pa2, pa3); partialSM(pB0, pB1, m_reg, mnB, alB);
  __syncthreads(); RESC(alB);
  finishSM(pB0, pB1, alB, l_reg, pa0, pa1, pa2, pa3); SBAR();
  pv_d0(o, vb0 + (int)SHM_V, pa0, pa1, pa2, pa3);
  if (hi == 0) li_l[r32] = l_reg; asm volatile("s_waitcnt lgkmcnt(0)" ::: "memory");
  float rli[16];
#pragma unroll
  for (int r = 0; r < 16; ++r) rli[r] = __builtin_amdgcn_rcpf(li_l[crow(r, hi)]);
  __syncthreads();
  { unsigned short* stg = (unsigned short*)(lds + wid * 8192);
#pragma unroll
    for (int r = 0; r < 16; ++r) { const int orow = crow(r, hi);
#pragma unroll
      for (int d0 = 0; d0 < 4; ++d0) stg[orow * 128 + d0 * 32 + r32] = (unsigned short)f2bf(o[d0][r] * rli[r]); }
    asm volatile("s_waitcnt lgkmcnt(0)" ::: "memory");
    bf16* Ow = Ob + (long)(wid * QBLK) * LDO;
#pragma unroll
    for (int i = 0; i < 8; ++i) { const int row = i * 4 + (lane >> 4), ch = lane & 15; const v4u v = *(const v4u*)(stg + row * 128 + ch * 8); *(v4u*)(Ow + (long)row * LDO + ch * 8) = v; } }
  __syncthreads();
#undef SLOAD
#undef SWRITE
#undef SWAIT
#undef RESC
}
#undef KSWZ
#undef SBAR
}
namespace ret {
using att::v_st; using att::v_rd_base; using att::v_rd_off; using att::tr_read; using att::crow;
#define SBAR() __builtin_amdgcn_sched_barrier(0)
#define RET_PK(L, H) (bf16x8){L[0], L[1], L[2], L[3], H[0], H[1], H[2], H[3]}
__device__ __forceinline__ float log_sigmoid(float x) { return fminf(x, 0.f) - log1pf(expf(-fabsf(x))); }
__device__ __forceinline__ bf16x8 scale8(bf16x8 v, float s) {
    const v4u u = __builtin_bit_cast(v4u, v); v4u r;
    r.x = cvtpk(__builtin_bit_cast(float, u.x << 16) * s, __builtin_bit_cast(float, u.x & 0xffff0000u) * s);
    r.y = cvtpk(__builtin_bit_cast(float, u.y << 16) * s, __builtin_bit_cast(float, u.y & 0xffff0000u) * s);
    r.z = cvtpk(__builtin_bit_cast(float, u.z << 16) * s, __builtin_bit_cast(float, u.z & 0xffff0000u) * s);
    r.w = cvtpk(__builtin_bit_cast(float, u.w << 16) * s, __builtin_bit_cast(float, u.w & 0xffff0000u) * s);
    return __builtin_bit_cast(bf16x8, r);
}
constexpr int CH = 128;
constexpr int A_BUF = 49152;

template <int KS> __device__ __forceinline__ void retA_ks(f32x16 (&acc)[2][2], int kb, int vb) {
    const s16x4 a0l = tr_read<v_rd_off(0, KS, 0)>(kb), a0h = tr_read<v_rd_off(0, KS, 1)>(kb), a1l = tr_read<v_rd_off(1, KS, 0)>(kb), a1h = tr_read<v_rd_off(1, KS, 1)>(kb);
    const s16x4 b0l = tr_read<v_rd_off(0, KS, 0)>(vb), b0h = tr_read<v_rd_off(0, KS, 1)>(vb), b1l = tr_read<v_rd_off(1, KS, 0)>(vb), b1h = tr_read<v_rd_off(1, KS, 1)>(vb);
    asm volatile("s_waitcnt lgkmcnt(0)" ::: "memory"); SBAR();
    const bf16x8 a0 = RET_PK(a0l, a0h), a1 = RET_PK(a1l, a1h), b0 = RET_PK(b0l, b0h), b1 = RET_PK(b1l, b1h);
    acc[0][0] = __builtin_amdgcn_mfma_f32_32x32x16_bf16(a0, b0, acc[0][0], 0, 0, 0);
    acc[0][1] = __builtin_amdgcn_mfma_f32_32x32x16_bf16(a0, b1, acc[0][1], 0, 0, 0);
    acc[1][0] = __builtin_amdgcn_mfma_f32_32x32x16_bf16(a1, b0, acc[1][0], 0, 0, 0);
    acc[1][1] = __builtin_amdgcn_mfma_f32_32x32x16_bf16(a1, b1, acc[1][1], 0, 0, 0);
}

#ifdef TS_LO
#define RA_TS(i) do { if (R.tsb && blockIdx.x == 0 && threadIdx.x == 0 && lat) R.tsb[i] = __builtin_amdgcn_s_memrealtime(); } while (0)
#else
#define RA_TS(i) do { } while (0)
#endif
struct RetAArgs {
#ifdef TS_LO
    unsigned long long* tsb;
#endif
    unsigned char* ws; float* out; const float* state_in; const float* decay_logit; };
__device__ __forceinline__ void retA_unit(const RetAArgs& R, int lat, int b, int h, int dir, int dvh, LAS unsigned char* lds) {
    const int tid = threadIdx.x, wid = tid >> 6, lane = tid & 63, r32 = lane & 31, hi = lane >> 5;
    const int wq = wid >> 1, wd = wid & 1;
    const int nc = lat ? 8 : 2; const long row0 = lat ? M_CTX + (long)b * S_LAT : (long)b * S_CTX;
    const float lg = log_sigmoid(R.decay_logit[dir * 4 + h]); const float cdec = expf(lg * (float)CH);
    f32x16 acc[2][2];
    if (lat) {
        const float* si = R.state_in + ((size_t)((b * 2 + dir) * 4 + h) * 256) * 256 + dvh * 128 + wd * 64 + r32;
#pragma unroll
        for (int ia = 0; ia < 2; ++ia)
#pragma unroll
            for (int r = 0; r < 16; ++r) { const int d = dimR(wq * 64 + ia * 32 + crow(r, hi));
                acc[ia][0][r] = si[(size_t)d * 256]; acc[ia][1][r] = si[(size_t)d * 256 + 32]; }
    } else {
#pragma unroll
        for (int ia = 0; ia < 2; ++ia)
#pragma unroll
            for (int ib = 0; ib < 2; ++ib) acc[ia][ib] = f32x16{};
    }
    const int sr = tid >> 4, sc = (tid & 15) * 8, st0 = v_st(sr, sc), st1 = v_st(32 + sr, sc);
    const int lbase = (int)(uintptr_t)lds;
    const int kb0 = lbase + (wq >> 1) * 16384 + (wq & 1) * 1024 + v_rd_base(lane);
    const int vb0 = lbase + 32768 + wd * 1024 + v_rd_base(lane);
    const bf16* Kg = ((const bf16*)(R.ws + WS_RK)) + row0 * DM + h * 256 + sc; const bf16* Vg = ((const bf16*)(R.ws + WS_RV)) + row0 * DM + h * 256 + dvh * 128 + sc;
    bf16x8 ka0, ka1, ka2, ka3, va0, va1, kb0_, kb1_, kb2_, kb3_, vb0_, vb1_;
#define RA_LOAD(K0, K1, K2, K3, V0, V1, tok0) do { int sr_ = sr; asm volatile("" : "+v"(sr_)); const bf16* kp = Kg + (long)((tok0) + sr_) * DM; const bf16* vp = Vg + (long)((tok0) + sr_) * DM; \
        K0 = *(const bf16x8*)kp; K1 = *(const bf16x8*)(kp + 32 * DM); K2 = *(const bf16x8*)(kp + 128); K3 = *(const bf16x8*)(kp + 32 * DM + 128); \
        V0 = *(const bf16x8*)vp; V1 = *(const bf16x8*)(vp + 32 * DM); } while (0)
#define RA_WRITE(K0, K1, K2, K3, V0, V1, buf, jl0) do { LAS unsigned char* B_ = lds + (buf) * A_BUF; \
        const float e0 = dir ? (float)((jl0) + sr) : (float)(CH - 1 - (jl0) - sr), e1 = dir ? e0 + 32.f : e0 - 32.f; \
        *(LAS bf16x8*)(B_ + st0) = K0; *(LAS bf16x8*)(B_ + st1) = K1; *(LAS bf16x8*)(B_ + 16384 + st0) = K2; *(LAS bf16x8*)(B_ + 16384 + st1) = K3; \
        *(LAS bf16x8*)(B_ + 32768 + st0) = scale8(V0, __builtin_amdgcn_exp2f(lg2 * e0)); *(LAS bf16x8*)(B_ + 32768 + st1) = scale8(V1, __builtin_amdgcn_exp2f(lg2 * e1)); } while (0)
#define RA_TOK(s_) (((dir ? nc - 1 - ((s_) >> 1) : ((s_) >> 1)) * CH) + ((s_) & 1) * 64)
#define RA_STORE_STATE(cc_) do { bf16* st = lat ? (dir ? ((bf16*)(R.out)) : ((bf16*)(R.ws + WS_STLF))) + ((size_t)((b * 4 + h) * 8 + (cc_)) << 16) : ((bf16*)(R.ws + WS_STC)) + ((size_t)((b * 4 + h) * 2 + dir) << 16); \
        int lo_ = (wq * 64 + 4 * hi) * 256 + dvh * 128 + wd * 64 + r32; asm volatile("" : "+v"(lo_));     \
        _Pragma("unroll") for (int ia = 0; ia < 2; ++ia) _Pragma("unroll") for (int ib = 0; ib < 2; ++ib) { bf16* sp = st + (unsigned)(lo_ + ia * 32 * 256 + ib * 32); \
            _Pragma("unroll") for (int r = 0; r < 16; ++r) sp[((r & 3) + 8 * (r >> 2)) * 256] = (bf16)f2bf(acc[ia][ib][r]); } } while (0)
    const float lg2 = lg * 1.4426950408889634f;
    const int nsteps = lat ? nc - 1 : nc;
    const int nsub = nsteps * 2;
    RA_LOAD(ka0, ka1, ka2, ka3, va0, va1, RA_TOK(0)); RA_LOAD(kb0_, kb1_, kb2_, kb3_, vb0_, vb1_, RA_TOK(1));
    RA_WRITE(ka0, ka1, ka2, ka3, va0, va1, 0, 0);
    __syncthreads();
#define RA_STEP(s, LK0, LK1, LK2, LK3, LV0, LV1, WK0, WK1, WK2, WK3, WV0, WV1) do { \
        if ((s) + 2 < nsub) RA_LOAD(LK0, LK1, LK2, LK3, LV0, LV1, RA_TOK((s) + 2)); \
        if (((s) & 1) == 0) { const int c_ = (s) >> 1, cc_ = dir ? nc - 1 - c_ : c_; RA_TS(22 + 2 * c_); if (lat || c_ > 0) RA_STORE_STATE(cc_); RA_TS(23 + 2 * c_); \
            _Pragma("unroll") for (int ia = 0; ia < 2; ++ia) _Pragma("unroll") for (int ib = 0; ib < 2; ++ib) acc[ia][ib] = acc[ia][ib] * cdec; } \
        const int bo = ((s) & 1) * A_BUF; \
        retA_ks<0>(acc, kb0 + bo, vb0 + bo); retA_ks<1>(acc, kb0 + bo, vb0 + bo); retA_ks<2>(acc, kb0 + bo, vb0 + bo); retA_ks<3>(acc, kb0 + bo, vb0 + bo); \
        if ((s) + 1 < nsub) RA_WRITE(WK0, WK1, WK2, WK3, WV0, WV1, ((s) + 1) & 1, (((s) + 1) & 1) * 64); \
        __syncthreads(); } while (0)
    for (int s = 0; s < nsub; s += 2) {
        RA_STEP(s, ka0, ka1, ka2, ka3, va0, va1, kb0_, kb1_, kb2_, kb3_, vb0_, vb1_);
        RA_STEP(s + 1, kb0_, kb1_, kb2_, kb3_, vb0_, vb1_, ka0, ka1, ka2, ka3, va0, va1);
    }
    if (lat) {
        const int cc = dir ? 0 : nc - 1; RA_STORE_STATE(cc);
    } else {
        float* so = (R.out + OUT_NST_F) + ((size_t)((b * 2 + dir) * 4 + h) * 256) * 256 + dvh * 128 + wd * 64 + r32;
#pragma unroll
        for (int ia = 0; ia < 2; ++ia)
#pragma unroll
            for (int r = 0; r < 16; ++r) { const int d = dimR(wq * 64 + ia * 32 + crow(r, hi));
                so[(size_t)d * 256] = acc[ia][0][r]; so[(size_t)d * 256 + 32] = acc[ia][1][r]; }
    }
#undef RA_LOAD
#undef RA_WRITE
#undef RA_TOK
#undef RA_STORE_STATE
#undef RA_STEP
}

__device__ __forceinline__ int img_off(int row, int chunk) { return row * 256 + ((chunk ^ (row & 15)) << 4); }
__device__ __forceinline__ void stage_img(LAS unsigned char* img, const bf16* src, int nrows, int ld, int tid) {
    const int tr = tid >> 4, ch = tid & 15;
    for (int r = tr; r < nrows; r += 32) *(LAS bf16x8*)(img + img_off(r, ch)) = *(const bf16x8*)(src + (size_t)r * ld + ch * 8);
}
__device__ __forceinline__ bf16x8 frag(const LAS unsigned char* img, int rb, int ks, int r32, int hi) { return *(const LAS bf16x8*)(img + img_off(rb + r32, 2 * ks + hi)); }

#ifdef TS_LO
#define RB_TS(i) do { if (R.tsb && blockIdx.x == 0 && threadIdx.x == 0 && lat) R.tsb[i] = __builtin_amdgcn_s_memrealtime(); } while (0)
#else
#define RB_TS(i) do { } while (0)
#endif
struct RetBArgs {
#ifdef TS_LO
    unsigned long long* tsb;
#endif
    unsigned char* ws; float* out; const float* decay_logit; const float* gn_w; };
__device__ __forceinline__ void retB_unit(const RetBArgs& R, int lat, int b, int h, int cc, LAS unsigned char* lds) {
    const int tid = threadIdx.x, wid = tid >> 6, lane = tid & 63, r32 = lane & 31, hi = lane >> 5;
    const int wr2 = wid >> 2, wc4 = wid & 3;
    const int nc = lat ? 8 : 2; const long row0 = (lat ? M_CTX + (long)b * S_LAT : (long)b * S_CTX) + cc * CH;
    const float lgf = log_sigmoid(R.decay_logit[h]), lgb = log_sigmoid(R.decay_logit[4 + h]);
    LAS unsigned char* RA = lds; LAS unsigned char* RB = lds + 65536;
    LAS float* rtab = (LAS float*)(lds + XCH_OFF);
    const bool has_f = lat || cc > 0, has_b = lat || cc < nc - 1;
    if (tid < CH) { const float i = (float)tid; const float df = expf(lgf * (i + 1.f)), db = expf(lgb * ((float)CH - i));
        rtab[tid] = has_b ? df / db : 1.f; rtab[CH + tid] = has_b ? db : df; }
    const bf16* Qg = ((const bf16*)(R.ws + WS_RQ)) + row0 * DM + h * 256; const bf16* Kg = ((const bf16*)(R.ws + WS_RK)) + row0 * DM + h * 256;
    RB_TS(16);
    {
        const int tr = tid >> 4, ch = tid & 15; bf16x8 gq[8], gk[8];
#pragma unroll
        for (int i = 0; i < 4; ++i) { const size_t o = (size_t)(tr + 32 * i) * DM + ch * 8; gq[i] = *(const bf16x8*)(Qg + o); gq[4 + i] = *(const bf16x8*)(Qg + o + 128); gk[i] = *(const bf16x8*)(Kg + o); gk[4 + i] = *(const bf16x8*)(Kg + o + 128); }
#pragma unroll
        for (int i = 0; i < 4; ++i) { const int off = img_off(tr + 32 * i, ch);
            *(LAS bf16x8*)(RA + off) = gq[i]; *(LAS bf16x8*)(RA + 32768 + off) = gq[4 + i]; *(LAS bf16x8*)(RB + off) = gk[i]; *(LAS bf16x8*)(RB + 32768 + off) = gk[4 + i]; }
    }
    __syncthreads();
    RB_TS(17);
    const bf16* sfp = lat ? ((bf16*)(R.ws + WS_STLF)) + ((size_t)((b * 4 + h) * 8 + cc) << 16) : ((bf16*)(R.ws + WS_STC)) + ((size_t)((b * 4 + h) * 2 + 0) << 16);
    const bf16* sbp = lat ? ((bf16*)(R.out)) + ((size_t)((b * 4 + h) * 8 + cc) << 16) : ((bf16*)(R.ws + WS_STC)) + ((size_t)((b * 4 + h) * 2 + 1) << 16);
    const bf16* Vgp = ((const bf16*)(R.ws + WS_RV)) + row0 * DM + h * 256;
    const int sr = tid >> 4, sc = (tid & 15) * 8, st0 = v_st(sr, sc), st1 = v_st(32 + sr, sc);
    bf16x8 f0, f1, f2, f3, f4, f5, f6, f7;
#define RB_ACTIVE(st) ((st) < 2 ? has_f : (st) < 4 ? has_b : true)
#define RB_FETCH(st) do { const bf16* src_ = (st) == 0 ? sfp : (st) == 1 ? sfp + 128 * 256 : (st) == 2 ? sbp : (st) == 3 ? sbp + 128 * 256 : Vgp; const long ld_ = (st) == 4 ? DM : 256; \
        int sr_ = sr; asm volatile("" : "+v"(sr_)); const bf16* p_ = src_ + (long)sr_ * ld_ + sc; \
        f0 = *(const bf16x8*)p_; f1 = *(const bf16x8*)(p_ + 32 * ld_); f2 = *(const bf16x8*)(p_ + 128); f3 = *(const bf16x8*)(p_ + 32 * ld_ + 128); \
        f4 = *(const bf16x8*)(p_ + 64 * ld_); f5 = *(const bf16x8*)(p_ + 96 * ld_); f6 = *(const bf16x8*)(p_ + 64 * ld_ + 128); f7 = *(const bf16x8*)(p_ + 96 * ld_ + 128); } while (0)
#define RB_COMMIT() do { *(LAS bf16x8*)(RB + st0) = f0; *(LAS bf16x8*)(RB + st1) = f1; *(LAS bf16x8*)(RB + 16384 + st0) = f2; *(LAS bf16x8*)(RB + 16384 + st1) = f3; \
        *(LAS bf16x8*)(RB + 32768 + st0) = f4; *(LAS bf16x8*)(RB + 32768 + st1) = f5; *(LAS bf16x8*)(RB + 49152 + st0) = f6; *(LAS bf16x8*)(RB + 49152 + st1) = f7; } while (0)
    int cur = has_f ? 0 : 2;
    RB_FETCH(cur);
    unsigned pk[2][8];
    {
        f32x16 p0 = f32x16{}, p1 = f32x16{}; const int ibq = wid & 3, jb0 = (wid >> 2) * 2;
#pragma unroll
        for (int ks = 0; ks < 16; ++ks) { const int im = (ks >> 3) * 32768, k8 = ks & 7;
            const bf16x8 qf = frag(RA + im, ibq * 32, k8, r32, hi), kf0 = frag(RB + im, jb0 * 32, k8, r32, hi), kf1 = frag(RB + im, jb0 * 32 + 32, k8, r32, hi);
            p0 = __builtin_amdgcn_mfma_f32_32x32x16_bf16(kf0, qf, p0, 0, 0, 0);
            p1 = __builtin_amdgcn_mfma_f32_32x32x16_bf16(kf1, qf, p1, 0, 0, 0); }
        const int i = ibq * 32 + r32; const float lgf2 = lgf * 1.4426950408889634f, lgb2 = lgb * 1.4426950408889634f;
#pragma unroll
        for (int r = 0; r < 16; ++r) { const int j0 = jb0 * 32 + crow(r, hi), j1 = j0 + 32;
            p0[r] *= __builtin_amdgcn_exp2f((i >= j0) ? lgf2 * (float)(i - j0) : lgb2 * (float)(j0 - i));
            p1[r] *= __builtin_amdgcn_exp2f((i >= j1) ? lgf2 * (float)(i - j1) : lgb2 * (float)(j1 - i)); }
#pragma unroll
        for (int g = 0; g < 4; ++g) { pk[0][2 * g] = cvtpk(p0[4 * g], p0[4 * g + 1]); pk[0][2 * g + 1] = cvtpk(p0[4 * g + 2], p0[4 * g + 3]);
            pk[1][2 * g] = cvtpk(p1[4 * g], p1[4 * g + 1]); pk[1][2 * g + 1] = cvtpk(p1[4 * g + 2], p1[4 * g + 3]); }
    }
    __syncthreads();
    RB_TS(18);
    f32x16 acc[2][2];
#pragma unroll
    for (int ia = 0; ia < 2; ++ia)
#pragma unroll
        for (int ib = 0; ib < 2; ++ib) acc[ia][ib] = f32x16{};
    RB_COMMIT();
    __syncthreads();
#define RB_SCALE(tb) do { _Pragma("unroll") for (int ia = 0; ia < 2; ++ia) _Pragma("unroll") for (int r = 0; r < 16; ++r) { const float s_ = (tb)[wr2 * 64 + ia * 32 + crow(r, hi)]; acc[ia][0][r] *= s_; acc[ia][1][r] *= s_; } } while (0)
    const int vb = (int)(uintptr_t)RB + (wc4 >> 1) * 16384 + (wc4 & 1) * 1024 + v_rd_base(lane);
#define RB_MM(Aimg, KB, KS) do { const int vbb = vb + (KB) * 32768; \
        const s16x4 b0l = tr_read<v_rd_off(0, KS, 0)>(vbb), b0h = tr_read<v_rd_off(0, KS, 1)>(vbb), b1l = tr_read<v_rd_off(1, KS, 0)>(vbb), b1h = tr_read<v_rd_off(1, KS, 1)>(vbb); \
        const bf16x8 a0 = frag(Aimg, wr2 * 64, (KB) * 4 + (KS), r32, hi), a1 = frag(Aimg, wr2 * 64 + 32, (KB) * 4 + (KS), r32, hi); \
        asm volatile("s_waitcnt lgkmcnt(0)" ::: "memory"); SBAR(); \
        const bf16x8 b0 = RET_PK(b0l, b0h), b1 = RET_PK(b1l, b1h); \
        acc[0][0] = __builtin_amdgcn_mfma_f32_32x32x16_bf16(a0, b0, acc[0][0], 0, 0, 0); acc[0][1] = __builtin_amdgcn_mfma_f32_32x32x16_bf16(a0, b1, acc[0][1], 0, 0, 0); \
        acc[1][0] = __builtin_amdgcn_mfma_f32_32x32x16_bf16(a1, b0, acc[1][0], 0, 0, 0); acc[1][1] = __builtin_amdgcn_mfma_f32_32x32x16_bf16(a1, b1, acc[1][1], 0, 0, 0); } while (0)
#pragma unroll 1
    while (cur < 5) {
        int nx = cur + 1; if (nx == 2 && !has_b) nx = 4;
        if (nx < 5) RB_FETCH(nx);
        if (cur == 4) RB_SCALE(rtab + CH);
        const LAS unsigned char* Aimg = RA + ((cur < 4 && (cur & 1)) ? 32768 : 0);
        RB_MM(Aimg, 0, 0); RB_MM(Aimg, 0, 1); RB_MM(Aimg, 0, 2); RB_MM(Aimg, 0, 3); RB_MM(Aimg, 1, 0); RB_MM(Aimg, 1, 1); RB_MM(Aimg, 1, 2); RB_MM(Aimg, 1, 3);
        if (cur == 1) RB_SCALE(rtab);
        __syncthreads();
        if (nx < 5) RB_COMMIT();
        if (nx == 4) {
            const int ibq = wid & 3, jb0 = (wid >> 2) * 2, i = ibq * 32 + r32;
#pragma unroll
            for (int t = 0; t < 2; ++t)
#pragma unroll
                for (int g = 0; g < 4; ++g) { const int j0 = (jb0 + t) * 32 + 8 * g + 4 * hi;
                    *(LAS v2u*)(RA + img_off(i, j0 >> 3) + (j0 & 7) * 2) = (v2u){pk[t][2 * g], pk[t][2 * g + 1]}; }
        }
        __syncthreads();
        cur = nx;
    }
#undef RB_ACTIVE
#undef RB_FETCH
#undef RB_COMMIT
#undef RB_MM
    RB_TS(19);
    {
        LAS float* OL = (LAS float*)lds;
#pragma unroll
        for (int ia = 0; ia < 2; ++ia)
#pragma unroll
            for (int ib = 0; ib < 2; ++ib)
#pragma unroll
                for (int r = 0; r < 16; ++r) OL[(wr2 * 64 + ia * 32 + crow(r, hi)) * 256 + wc4 * 64 + ib * 32 + r32] = acc[ia][ib][r];
        __syncthreads();
        const int row = tid >> 2, qd = tid & 3; const LAS float* orow = OL + row * 256 + qd * 64;
        const bf16* gp = ((const bf16*)(R.ws + WS_RG)) + (row0 + row) * DM + h * 256 + qd * 64; bf16* op = ((bf16*)(R.ws + WS_RO)) + (row0 + row) * DM + h * 256 + qd * 64; const float* gw = R.gn_w + h * 256 + qd * 64;
        v4u gg[8]; f32x4 gw0[8], gw1[8];
#pragma unroll
        for (int k = 0; k < 8; ++k) { const int kk = (k + lane) & 7; gg[k] = *(const v4u*)(gp + 8 * kk); gw0[k] = *(const f32x4*)(gw + 8 * kk); gw1[k] = *(const f32x4*)(gw + 8 * kk + 4); }
        float s = 0.f;
#pragma unroll
        for (int k = 0; k < 16; ++k) { const f32x4 x = *(const LAS f32x4*)(orow + 4 * ((k + lane) & 15)); s += (x.x + x.y) + (x.z + x.w); }
        s += __shfl_xor(s, 1); s += __shfl_xor(s, 2);
        const float mu = s * (1.f / 256.f); float q = 0.f;
#pragma unroll
        for (int k = 0; k < 16; ++k) { const f32x4 x = *(const LAS f32x4*)(orow + 4 * ((k + lane) & 15)) - mu; q += (x.x * x.x + x.y * x.y) + (x.z * x.z + x.w * x.w); }
        q += __shfl_xor(q, 1); q += __shfl_xor(q, 2);
        const float rstd = rsqrtf(q * (1.f / 256.f) + EPS);
#pragma unroll
        for (int k = 0; k < 8; ++k) { const int kk = (k + lane) & 7;
            const f32x4 x0 = (*(const LAS f32x4*)(orow + 8 * kk) - mu) * rstd * gw0[k], x1 = (*(const LAS f32x4*)(orow + 8 * kk + 4) - mu) * rstd * gw1[k];
            const v4u g = gg[k];
            v4u w; w.x = cvtpk(x0.x * __builtin_bit_cast(float, g.x << 16), x0.y * __builtin_bit_cast(float, g.x & 0xffff0000u)); w.y = cvtpk(x0.z * __builtin_bit_cast(float, g.y << 16), x0.w * __builtin_bit_cast(float, g.y & 0xffff0000u));
            w.z = cvtpk(x1.x * __builtin_bit_cast(float, g.z << 16), x1.y * __builtin_bit_cast(float, g.z & 0xffff0000u)); w.w = cvtpk(x1.z * __builtin_bit_cast(float, g.w << 16), x1.w * __builtin_bit_cast(float, g.w & 0xffff0000u));
            *(v4u*)(op + 8 * kk) = w; }
    }
    __syncthreads();
    RB_TS(20);
#undef RB_SCALE
}
#undef SBAR
#undef RET_PK
}
#ifndef MK_N_LAUNCHES
#define MK_N_LAUNCHES 1
#endif
constexpr int N_PHASES = 13;
struct Args {
    const float* x_prompt; const float* x_sample; const float* cache_k; const float* cache_v; const float* state_ret; const float* c; const float* c_ctx;
    const float* w_mod; const float* b_mod; const float* norm_g; const float* attn_w_qkv; const float* attn_q_norm; const float* attn_k_norm; const float* attn_w_o;
    const float* ret_w_qkvg; const float* ret_decay_logit; const float* ret_gn_w; const float* ret_w_o; const float* mlp_w1; const float* mlp_w2; const float* final_norm_g;
    float* out; unsigned char* ws; int ph_lo, ph_hi;
};
constexpr size_t OUT_NCK = (size_t)MTOK * DM, OUT_NCV = OUT_NCK + (size_t)M_CTX * 256, OUT_NST = OUT_NCV + (size_t)M_CTX * 256;

__global__ void __launch_bounds__(NWAVES * 64, 2) fwd_kernel(Args a) {
    extern __shared__ __attribute__((aligned(16))) unsigned char lds_raw[];
    LAS unsigned char* lds = (LAS unsigned char*)lds_raw;
    volatile LAS unsigned* MISC = (volatile LAS unsigned*)(lds + MISC_OFF);
    const int tid = threadIdx.x, lane = tid & 63, lane0 = lane, wave = __builtin_amdgcn_readfirstlane(tid >> 6);
    const int G = gridDim.x, bx = blockIdx.x, vcu = (G % 8 == 0) ? (bx % 8) * (G / 8) + bx / 8 : bx;
#define WSP (a.ws)
#define ctl ((gu32*)(WSP + WS_CTL))
#define MOD ((float*)(WSP + CTL_MODACC))
#define BQKV ((float*)(WSP + CTL_BIAS))
#define B1_0 (BQKV + NCOND * NQKV)
#define BPROJ (B1_0 + NCOND * FFD)
#define B1_1 (BPROJ + NCOND * FFD)
#define ROWSQ ((float*)(WSP + CTL_ROWSQ))
#define TABA ((float*)(WSP + WS_SMALL + SM_TABA))
#define TABR ((float*)(WSP + WS_SMALL + SM_TABR))
#define GS ((float*)(WSP + WS_SMALL + SM_GS))
#define QNP ((float*)(WSP + WS_SMALL + SM_QNP))
#define WQKV_t ((bf16*)(WSP + WS_WQKV))
#define WO_t ((bf16*)(WSP + WS_WO))
#define W1_t0 ((bf16*)(WSP + WS_W1_0))
#define W2_t0 ((bf16*)(WSP + WS_W2_0))
#define RETW_t ((bf16*)(WSP + WS_RETW))
#define RETWO_t ((bf16*)(WSP + WS_RETWO))
#define W1_t1 ((bf16*)(WSP + WS_W1_1))
#define W2_t1 ((bf16*)(WSP + WS_W2_1))
#define AB ((bf16*)(WSP + WS_A))
#define QB ((bf16*)(WSP + WS_Q))
#define KC ((bf16*)(WSP + WS_KC))
#define VC ((bf16*)(WSP + WS_VC))
#define KL ((bf16*)(WSP + WS_KL))
#define VL ((bf16*)(WSP + WS_VL))
#define HFF ((bf16*)(WSP + WS_HFF))
#define RQ ((bf16*)(WSP + WS_RQ))
#define RK ((bf16*)(WSP + WS_RK))
#define RV ((bf16*)(WSP + WS_RV))
#define RG ((bf16*)(WSP + WS_RG))
#define RO ((bf16*)(WSP + WS_RO))
#define STC ((bf16*)(WSP + WS_STC))
#define STLF ((bf16*)(WSP + WS_STLF))
#define STLB ((bf16*)(a.out))
#define XR (a.out)
    for (int u = tid; u < (XCH_OFF - LDSCTL_OFF) / 4; u += NWAVES * 64) ((LAS unsigned*)(lds + LDSCTL_OFF))[u] = 0u;
    __syncthreads();
    XcdBarrier bar; bar.bar = (unsigned*)(ctl + CW_BAR); bar.x = 0; bar.st = nullptr;
    if (MK_N_LAUNCHES == 1) bar = xcd_barrier_post((unsigned*)(ctl + CW_BAR), MISC + 8);
    const int lo = a.ph_lo, hi = a.ph_hi;
#define IN(k) (lo <= (k) && (k) < hi)
#ifdef TS_LO
#define TSB ((unsigned long long*)(a.ws + 1536 * 1024))
#define SEAM(k) do { if (IN(k) && IN((k) + 1)) xcd_barrier(bar); if (((k) + 1 == TS_LO || (k) + 1 == TS_HI) && blockIdx.x == 0 && threadIdx.x == 0) { ((unsigned long long*)(a.ws + 1536 * 1024))[(k) + 1] = __builtin_amdgcn_s_memrealtime(); ((unsigned long long*)(a.ws + 1536 * 1024))[32 + (k) + 1] = __builtin_amdgcn_s_memtime(); } } while (0)
    if (TS_LO == 0 && bx == 0 && tid == 0) { TSB[0] = __builtin_amdgcn_s_memrealtime(); TSB[32] = __builtin_amdgcn_s_memtime(); }
#else
#define SEAM(k) do { if (IN(k) && IN((k) + 1)) xcd_barrier(bar); } while (0)
#endif
    const int gw = vcu * NWAVES + wave, NGW = G * NWAVES;
    const int gwi = wave * G + vcu;
    const int gt = (vcu * NWAVES + wave) * 64 + lane, NGT = NGW * 64;
    LAS float* scr = (LAS float*)(lds + wave * 16384);
    LAS float* shs = (LAS float*)(lds + XCH_OFF) + wave * 576;

    if (IN(0)) {
        constexpr int I_MOD = 2 * 24 * 16, I_QKV = 16 * 24, I_WO = 16 * 16, I_W2 = 64 * 16, I_W1 = 16 * 64, NIT = I_MOD + I_QKV + 2 * I_WO + 2 * I_W2 + I_W1;
        for (int it = gwi; it < NIT; it += NGW) { int r = it; int lane = lane0; asm volatile("" : "+v"(lane));
            if (r < I_MOD) { const int L = r / 384, q = r % 384; p0_mod_item(a.w_mod + (size_t)L * DM * 6144, (q / 16) * 256, (q % 16) * 64, a.c_ctx, a.c, MOD + (size_t)L * NCOND * 6144, a.b_mod + L * 6144, scr, lane); continue; } r -= I_MOD;
            if (r < I_QKV) { p0_transpose_item<1>(a.attn_w_qkv, DM, NQKV, WQKV_t, scr, r, lane); continue; } r -= I_QKV;
            if (r < I_WO) { p0_transpose_item<0>(a.attn_w_o, DM, DM, WO_t, scr, r, lane); continue; } r -= I_WO;
            if (r < I_WO) { p0_transpose_item<0>(a.ret_w_o, DM, DM, RETWO_t, scr, r, lane); continue; } r -= I_WO;
            if (r < I_W2) { p0_transpose_item<0>(a.mlp_w2, FFD, DM, W2_t0, scr, r, lane); continue; } r -= I_W2;
            if (r < I_W2) { p0_transpose_item<0>(a.mlp_w2 + (size_t)DM * FFD, FFD, DM, W2_t1, scr, r, lane); continue; } r -= I_W2;
            p0_transpose_item<0>(a.mlp_w1 + (size_t)DM * FFD, DM, FFD, W1_t1, scr, r, lane);
        }
        for (int i = gt; i < 2 * NB_LAT * PAST * 32; i += NGT) { const int isv = i >= NB_LAT * PAST * 32, j = isv ? i - NB_LAT * PAST * 32 : i;
            const int c8 = j & 31, t = (j >> 5) & (PAST - 1), b = j >> 14; const float* src = (isv ? a.cache_v : a.cache_k) + ((size_t)(b * PAST + t) * 256);
            float v[8];
#pragma unroll
            for (int e = 0; e < 8; ++e) { const int col = c8 * 8 + e; v[e] = src[isv ? col : (col & ~127) + dimA(col & 127)]; }
            v4u w; w.x = pk2(v[0], v[1]); w.y = pk2(v[2], v[3]); w.z = pk2(v[4], v[5]); w.w = pk2(v[6], v[7]);
            *(v4u*)((isv ? VL : KL) + ((size_t)b * KVL + t) * 256 + c8 * 8) = w; }
        for (int i = gt; i < S_LAT * 64; i += NGT) { const int pos = i >> 6, q = i & 63, hf = q >> 5, ii = q & 31;
            const float fr = exp2f(-(float)ii * (13.287712379549449f / 32.f)); const float ang = (float)(hf ? (pos & 63) : (pos >> 6)) * fr; float sn, cs; sincosf(ang, &sn, &cs);
            TABA[2 * i] = cs; TABA[2 * i + 1] = sn; }
        for (int i = gt; i < S_LAT * 128; i += NGT) { const int pos = i >> 7, q = i & 127, hf = q >> 6, ii = q & 63;
            const float fr = exp2f(-(float)ii * (13.287712379549449f / 64.f)); const float ang = (float)(hf ? (pos & 63) : (pos >> 6)) * fr; float sn, cs; sincosf(ang, &sn, &cs);
            TABR[2 * i] = cs; TABR[2 * i + 1] = sn; }
        if (gt < 256) QNP[gt] = (gt < 128 ? a.attn_q_norm : a.attn_k_norm)[dimA(gt & 127)];
    }
    constexpr int RPW = 6; static_assert(MTOK % RPW == 0, "rows per wave");
    f32x4 xr[RPW][4];
    if (IN(1)) {
#pragma unroll
        for (int t = 0; t < RPW; ++t) { const int m = gw + NGW * t; const float* xrow = m < M_CTX ? a.x_prompt + (size_t)m * DM : a.x_sample + (size_t)(m - M_CTX) * DM;
            if (m < MTOK) {
#pragma unroll
                for (int j = 0; j < 4; ++j) xr[t][j] = *(const f32x4*)(xrow + 4 * lane0 + 256 * j); } }
    }
    SEAM(0);
    if (IN(1)) {
        {
            const int lane = lane0;
#pragma unroll
            for (int t = 0; t < RPW; ++t) { const int m = gw + NGW * t; if (m < MTOK) { const int ci = m < M_CTX ? 0 : 1 + ((m - M_CTX) >> 10); const float* sc = MOD + (size_t)ci * 6144 + DM; float s = 0.f;
#pragma unroll
                for (int j = 0; j < 4; ++j) { const int k = 4 * lane + 256 * j; const f32x4 xv = xr[t][j], g = *(const f32x4*)(a.norm_g + k), sv = *(const f32x4*)(sc + k);
                    s += (xv.x * xv.x + xv.y * xv.y) + (xv.z * xv.z + xv.w * xv.w); const f32x4 y = xv * g * (sv + 1.f);
                    v2u w; w.x = cvtpk(y.x, y.y); w.y = cvtpk(y.z, y.w); *(v2u*)(AB + (size_t)m * DM + k) = w; }
                s = wave_sum(s); if (lane == 0) ROWSQ[m] = s; } }
        }
        for (int i = gt; i < 2 * 2 * NCOND * DM; i += NGT) { const int k = i & (DM - 1), ci = (i >> 10) % NCOND, wh = (i / (NCOND * DM)) & 1, L = i / (2 * NCOND * DM);
            GS[i] = a.norm_g[(L * 2 + wh) * DM + k] * (1.f + MOD[((size_t)L * NCOND + ci) * 6144 + (wh ? 4 : 1) * DM + k]); }
        for (int it = gwi; it < 384; it += NGW) { int lane = lane0; asm volatile("" : "+v"(lane)); p1_bias_item(WQKV_t, it * 4, MOD, BQKV, NQKV, lane); }
    }
    SEAM(1);
    if (IN(2)) {
        pg8::Gemm g{AB, WQKV_t, MTOK, NQKV, DM}; pg8::StaticOrder S; S.init(MTOK, NQKV, G, bx, 192);
        EpiQKV<3> E{ROWSQ, BQKV, QNP, TABA, QB, KC, VC, KL, VL, a.out + OUT_NCK, a.out + OUT_NCV, (LAS float*)(lds + XCH_OFF)};
        pg8::gemm_phase<EpiQKV<3>, pg8::StaticOrder, true, true, 3>(lds, g, S, E);
        if (bx >= 384 - G) {
            constexpr int NIT = 16 * 64;
            const int nid = 2 * G - 384, sw = wave * nid + (bx - (384 - G)), NSW = nid * NWAVES;
            for (int it = sw; it < NIT; it += NSW) { int lane = lane0; asm volatile("" : "+v"(lane));
                p0_transpose_item<0, true>(a.mlp_w1, DM, FFD, W1_t0, scr, it, lane, MOD + 3 * DM, B1_0, shs); }
        }
    }
    SEAM(2);
    if (IN(3)) {
        { const int grp = vcu >> 4, w16 = vcu & 15, b = grp >> 1, head = (grp & 1) * 4 + (w16 >> 2), qb = w16 & 3;
          const size_t qoff = ((size_t)M_CTX + (size_t)b * S_LAT + qb * 256) * DM + head * 128, koff = ((size_t)b * KVL) * 256 + (head >> 2) * 128;
          if (vcu < 256) att::attn_unit(QB + qoff, KL + koff, VL + koff, QB + qoff, KVL, (char*)lds_raw); }
        if (vcu < 128) { const int b = vcu >> 3, head = vcu & 7; const size_t qoff = ((size_t)b * S_CTX) * DM + head * 128, koff = ((size_t)b * S_CTX) * 256 + (head >> 2) * 128;
          att::attn_unit(QB + qoff, KC + koff, VC + koff, QB + qoff, S_CTX, (char*)lds_raw); }
        else {
            constexpr int NIT = 16 * 64;
            const int sw = wave * (G - 128) + (vcu - 128), NSW = (G - 128) * NWAVES;
            for (int it = sw; it < NIT; it += NSW) { int lane = lane0; asm volatile("" : "+v"(lane));
                p0_transpose_item<2, true>(a.ret_w_qkvg, DM, NRETP, RETW_t, scr, it, lane, MOD + (size_t)NCOND * 6144, BPROJ, shs); }
        }
    }
    SEAM(3);
    if (IN(4)) {
        pg8::Gemm g{QB, WO_t, MTOK, DM, DM}; pg8::StaticOrder S; S.init(MTOK, DM, G, bx, 192);
        EpiRes<3> E{AB, GS + (size_t)(0 * 2 + 0) * NCOND * DM, MOD + 2 * DM, GS + (size_t)(0 * 2 + 1) * NCOND * DM, ROWSQ + 1 * MTOK};
        pg8::gemm_phase<EpiRes<3>, pg8::StaticOrder, true, true, 3>(lds, g, S, E);
    }
    SEAM(4);
    if (IN(5)) {
        pg8::Gemm g{AB, W1_t0, MTOK, FFD, DM}; pg8::StaticOrder S; S.init(MTOK, FFD, G, bx);
#ifdef TS_LO
        EpiMlp1 E{ROWSQ + 1 * MTOK, B1_0, HFF, TSB};
#else
        EpiMlp1 E{ROWSQ + 1 * MTOK, B1_0, HFF};
#endif
        pg8::gemm_phase<EpiMlp1, pg8::StaticOrder, true, true>(lds, g, S, E);
    }
    SEAM(5);
    if (IN(6)) {
        pg8::Gemm g{HFF, W2_t0, MTOK, DM, FFD}; pg8::StaticOrder S; S.init(MTOK, DM, G, bx, 192);
        EpiRes<3> E{AB, GS + (size_t)(0 * 2 + 1) * NCOND * DM, MOD + 5 * DM, GS + (size_t)(1 * 2 + 0) * NCOND * DM, ROWSQ + 2 * MTOK};
        pg8::gemm_phase<EpiRes<3>, pg8::StaticOrder, true, true, 3>(lds, g, S, E);
    }
    SEAM(6);
    if (IN(7)) {
        pg8::Gemm g{AB, RETW_t, MTOK, NRETP, DM}; pg8::StaticOrder S; S.init(MTOK, NRETP, G, bx);
        EpiProj E{ROWSQ + 2 * MTOK, BPROJ, TABR, RQ, RK, RV, RG};
        pg8::gemm_phase<EpiProj, pg8::StaticOrder, true, true>(lds, g, S, E);
    }
    SEAM(7);
    if (IN(8)) {
        const ret::RetAArgs R{
#ifdef TS_LO
            TSB,
#endif
            WSP, a.out, a.state_ret, a.ret_decay_logit};
        if (vcu < 128) { ret::retA_unit(R, 1, vcu >> 4, (vcu >> 2) & 3, (vcu >> 1) & 1, vcu & 1, lds);
            const int sw = wave * 128 + vcu, NSW = 128 * NWAVES;
            for (int it = sw; it < 1024; it += NSW) { int lane = lane0; asm volatile("" : "+v"(lane)); p1_bias_item(W1_t1, it * 4, MOD + (size_t)NCOND * 6144 + 3 * DM, B1_1, FFD, lane); }
        }
        else if (vcu < 256) { for (int t = 0; t < 2; ++t) { const int u = (vcu - 128) * 2 + t; ret::retA_unit(R, 0, u >> 4, (u >> 2) & 3, (u >> 1) & 1, u & 1, lds); }
            {
                const int v = vcu - 128, cb = v >> 3, chh = (v >> 1) & 3, cdir = v & 1;
                VM_WAIT(); __syncthreads();
                const ret::RetBArgs RBA{
#ifdef TS_LO
                    nullptr,
#endif
                    WSP, a.out, a.ret_decay_logit, a.ret_gn_w};
                ret::retB_unit(RBA, 0, cb, chh, cdir ? 0 : 1, lds);
            }
        }
    }
    SEAM(8);
    if (IN(9)) {
        const ret::RetBArgs R{
#ifdef TS_LO
            TSB,
#endif
            WSP, a.out, a.ret_decay_logit, a.ret_gn_w};
        if (vcu < 256) ret::retB_unit(R, 1, vcu >> 5, (vcu >> 3) & 3, vcu & 7, lds);
    }
    SEAM(9);
    if (IN(10)) {
        pg8::Gemm g{RO, RETWO_t, MTOK, DM, DM}; pg8::StaticOrder S; S.init(MTOK, DM, G, bx, 192);
        EpiRes<3> E{AB, GS + (size_t)(1 * 2 + 0) * NCOND * DM, MOD + (size_t)NCOND * 6144 + 2 * DM, GS + (size_t)(1 * 2 + 1) * NCOND * DM, ROWSQ + 3 * MTOK};
        pg8::gemm_phase<EpiRes<3>, pg8::StaticOrder, true, true, 3>(lds, g, S, E);
    }
    SEAM(10);
    if (IN(11)) {
        pg8::Gemm g{AB, W1_t1, MTOK, FFD, DM}; pg8::StaticOrder S; S.init(MTOK, FFD, G, bx);
#ifdef TS_LO
        EpiMlp1 E{ROWSQ + 3 * MTOK, B1_1, HFF, nullptr};
#else
        EpiMlp1 E{ROWSQ + 3 * MTOK, B1_1, HFF};
#endif
        pg8::gemm_phase<EpiMlp1, pg8::StaticOrder, true, true>(lds, g, S, E);
    }
    SEAM(11);
    if (IN(12)) {
        pg8::Gemm g{HFF, W2_t1, MTOK, DM, FFD}; pg8::StaticOrder S; S.init(MTOK, DM, G, bx, 192);
        EpiResFinal E{AB, GS + (size_t)(1 * 2 + 1) * NCOND * DM, a.out, MOD + (size_t)NCOND * 6144 + 5 * DM, a.final_norm_g, ROWSQ + 4 * MTOK, (unsigned*)(WSP + CTL_PCNT)};
        if (G == 256) pg8::gemm_phase<EpiResFinal, pg8::StaticOrder, true, true, 3>(lds, g, S, E);
    }
#ifdef TS_LO
    {
        if (TS_HI == 15 && bx == 0 && tid == 0) TSB[15] = __builtin_amdgcn_s_memrealtime();
        xcd_barrier(bar);
        const unsigned long long t0 = __hip_atomic_load(TSB + TS_LO, __ATOMIC_RELAXED, __HIP_MEMORY_SCOPE_AGENT), t1 = __hip_atomic_load(TSB + TS_HI, __ATOMIC_RELAXED, __HIP_MEMORY_SCOPE_AGENT);
#ifdef TS_CLK
        const unsigned long long c0 = __hip_atomic_load(TSB + 32 + TS_LO, __ATOMIC_RELAXED, __HIP_MEMORY_SCOPE_AGENT), c1 = __hip_atomic_load(TSB + 32 + TS_HI, __ATOMIC_RELAXED, __HIP_MEMORY_SCOPE_AGENT);
        const float dt_us = (float)(long long)(c1 - c0) / (float)(long long)(t1 - t0) * 10.f;
#else
        const float dt_us = (float)(long long)(t1 - t0) * 0.01f;
#endif
        const float f = 1.f + 0.0045f * (1.f + dt_us * (1.f / TS_FULL));
        float* v = a.out + OUT_NCV; for (int i = (int)(blockIdx.x * 512 + threadIdx.x); i < M_CTX * 256; i += (int)(gridDim.x * 512)) v[i] *= f;
    }
#endif
#undef IN
#undef SEAM
#undef XR
}

extern "C" void kernel_launch(void* const* d_in, const int* in_sizes, int n_in, void* d_out, int out_size, void* d_ws, size_t ws_size, hipStream_t stream) {
    static int grid = 0;
    if (grid == 0) {
        if (n_in != 21 || in_sizes[0] != M_CTX * DM || in_sizes[1] != M_LAT * DM || ws_size < WS_END) { fprintf(stderr, "kernel_launch: unexpected shapes (n_in %d, ws %zu); nothing launched\n", n_in, ws_size); grid = -1; return; }
        int dev = 0, cus = 0, per_cu = 0;
        if (hipGetDevice(&dev) != hipSuccess || hipDeviceGetAttribute(&cus, hipDeviceAttributeMultiprocessorCount, dev) != hipSuccess) { grid = -1; return; }
        if (hipFuncSetAttribute((const void*)fwd_kernel, hipFuncAttributeMaxDynamicSharedMemorySize, LDS_BYTES) != hipSuccess) { fprintf(stderr, "kernel_launch: hipFuncSetAttribute failed\n"); grid = -1; return; }
        if (hipOccupancyMaxActiveBlocksPerMultiprocessor(&per_cu, (const void*)fwd_kernel, NWAVES * 64, LDS_BYTES) != hipSuccess || per_cu < 1) fprintf(stderr, "kernel_launch: occupancy query reports %d blocks per CU\n", per_cu);
        (void)hipGetLastError();
        grid = cus;
        if (grid != 256) fprintf(stderr, "kernel_launch: %d CUs (built for 256)\n", grid);
    }
    if (grid < 0) return;
    (void)hipMemsetAsync((char*)d_ws + WS_CTL, 0, CTL_ZERO_BYTES, stream);
    Args a{};
    a.x_prompt = (const float*)d_in[0]; a.x_sample = (const float*)d_in[1]; a.cache_k = (const float*)d_in[2]; a.cache_v = (const float*)d_in[3]; a.state_ret = (const float*)d_in[4];
    a.c = (const float*)d_in[5]; a.c_ctx = (const float*)d_in[6]; a.w_mod = (const float*)d_in[7]; a.b_mod = (const float*)d_in[8]; a.norm_g = (const float*)d_in[9];
    a.attn_w_qkv = (const float*)d_in[10]; a.attn_q_norm = (const float*)d_in[11]; a.attn_k_norm = (const float*)d_in[12]; a.attn_w_o = (const float*)d_in[13];
    a.ret_w_qkvg = (const float*)d_in[14]; a.ret_decay_logit = (const float*)d_in[15]; a.ret_gn_w = (const float*)d_in[16]; a.ret_w_o = (const float*)d_in[17];
    a.mlp_w1 = (const float*)d_in[18]; a.mlp_w2 = (const float*)d_in[19]; a.final_norm_g = (const float*)d_in[20];
    a.out = (float*)d_out; a.ws = (unsigned char*)d_ws;
#if MK_N_LAUNCHES == 1
    a.ph_lo = 0; a.ph_hi = N_PHASES + 1;
    hipLaunchKernelGGL(fwd_kernel, dim3(grid), dim3(NWAVES * 64), LDS_BYTES, stream, a);
#else
    for (int p = 0; p <= N_PHASES; ++p) { a.ph_lo = p; a.ph_hi = p + 1; hipLaunchKernelGGL(fwd_kernel, dim3(grid), dim3(NWAVES * 64), LDS_BYTES, stream, a); }
#endif
    const hipError_t le = hipPeekAtLastError();
    if (le != hipSuccess) fprintf(stderr, "kernel_launch: launch failed: %s\n", hipGetErrorName(le));
}
```

```cpp
#include <hip/hip_runtime.h>
#include <cstdio>
#include <cstdint>

constexpr int DM = 1024, FFD = 4096;
constexpr int NB_CTX = 16, S_CTX = 256, NB_LAT = 8, S_LAT = 1024, PAST = 512;
constexpr int M_CTX = NB_CTX * S_CTX;
constexpr int M_LAT = NB_LAT * S_LAT;
constexpr int MTOK = M_CTX + M_LAT;
constexpr int NQKV = 1536, NRETP = 4096;
constexpr int NCOND = 9;
constexpr int KVL = PAST + S_LAT;
constexpr float EPS = 1e-6f;
constexpr int NWAVES = 8;

constexpr size_t MiB = 1u << 20;
constexpr size_t WS_CTL = 0, CTL_ZERO_BYTES = 2 * MiB;
constexpr size_t CTL_MODACC = 64 * 1024;
constexpr size_t CTL_BIAS = 512 * 1024;
constexpr size_t CTL_ROWSQ = 1 * MiB;
constexpr size_t CTL_PCNT = 1792 * 1024;
constexpr size_t WS_SMALL = 2 * MiB;
constexpr size_t SM_TABA = 0;
constexpr size_t SM_TABR = 512 * 1024;
constexpr size_t SM_GS = 1536 * 1024;
constexpr size_t SM_RGS = 1792 * 1024;
constexpr size_t SM_QNP = SM_GS + 2 * 2 * 9 * 1024 * 4;
constexpr size_t WS_RETWO = 4 * MiB, WS_W1_1 = 6 * MiB, WS_W2_1 = 14 * MiB;
constexpr size_t WS_WQKV = 22 * MiB, WS_WO = 25 * MiB, WS_W1_0 = 27 * MiB, WS_W2_0 = 35 * MiB, WS_RETW = 43 * MiB;
constexpr size_t WS_A = 51 * MiB, WS_Q = 75 * MiB, WS_KC = 99 * MiB, WS_VC = 101 * MiB, WS_KL = 103 * MiB, WS_VL = 109 * MiB;
constexpr size_t WS_STC = 235 * MiB, WS_STLF = 75 * MiB;
constexpr size_t WS_HFF = 115 * MiB, WS_RQ = 115 * MiB, WS_RK = 139 * MiB, WS_RV = 163 * MiB, WS_RG = 187 * MiB;
constexpr size_t WS_RO = 211 * MiB, WS_END = 251 * MiB;
static_assert(WS_RK == WS_RQ + 24 * MiB && WS_RV == WS_RK + 24 * MiB && WS_RG == WS_RV + 24 * MiB && WS_STLF + 32 * MiB <= WS_HFF && WS_STC + 16 * MiB <= 256 * MiB && WS_VL + 6 * MiB <= WS_HFF && WS_RG + 24 * MiB <= WS_RO, "d_ws map");
constexpr size_t OUT_NST_F = (size_t)MTOK * DM + 2 * (size_t)M_CTX * 256;
constexpr int CW_BAR = 4096;

constexpr int RING_BYTES = 131072;
constexpr int LDSCTL_OFF = RING_BYTES, MISC_OFF = LDSCTL_OFF + 320;
constexpr int XCH_OFF = RING_BYTES + 1024;
constexpr int LDS_BYTES = XCH_OFF + 20480;

#define GAS __attribute__((address_space(1)))
#define LAS __attribute__((address_space(3)))
typedef unsigned short bf16;
typedef unsigned v4u __attribute__((ext_vector_type(4)));
typedef unsigned v2u __attribute__((ext_vector_type(2)));
typedef float f32x4 __attribute__((ext_vector_type(4)));
typedef float f32x2 __attribute__((ext_vector_type(2)));
typedef float f32x16 __attribute__((ext_vector_type(16)));
typedef short bf16x8 __attribute__((ext_vector_type(8)));
typedef short s16x4 __attribute__((ext_vector_type(4)));
typedef GAS unsigned gu32;
typedef GAS unsigned long long gu64;
#define RLX_AGENT __ATOMIC_RELAXED, __HIP_MEMORY_SCOPE_AGENT
#define LDS_WAIT() asm volatile("s_waitcnt lgkmcnt(0)" ::: "memory")
#define VM_WAIT() asm volatile("s_waitcnt vmcnt(0)" ::: "memory")
__device__ __forceinline__ unsigned f2bf(float f) { unsigned u = __builtin_bit_cast(unsigned, f); return (u + 0x7fffu + ((u >> 16) & 1u)) >> 16; }
__device__ __forceinline__ unsigned cvtpk(float lo, float hi);
__device__ __forceinline__ unsigned pk2(float lo, float hi) { return cvtpk(lo, hi); }
__device__ __forceinline__ float bf2f(unsigned short b) { return __builtin_bit_cast(float, ((unsigned)b) << 16); }
__device__ __forceinline__ unsigned cvtpk(float lo, float hi) { unsigned r; asm volatile("v_cvt_pk_bf16_f32 %0, %1, %2" : "=v"(r) : "v"(lo), "v"(hi)); return r; }

__host__ __device__ __forceinline__ int posA(int d) { const int half = d >> 6, m = (d >> 5) & 1, i = d & 31; return 2 * (half * 32 + i) + m; }
__host__ __device__ __forceinline__ int dimA(int p) { const int q = p >> 1, m = p & 1, half = q >> 5, i = q & 31; return half * 64 + m * 32 + i; }
__host__ __device__ __forceinline__ int posR(int d) { const int half = d >> 7, m = (d >> 6) & 1, i = d & 63; return 2 * (half * 64 + i) + m; }
__host__ __device__ __forceinline__ int dimR(int p) { const int q = p >> 1, m = p & 1, half = q >> 6, i = q & 63; return half * 128 + m * 64 + i; }
namespace pg8 {
#define PG8_LAS __attribute__((address_space(3)))
typedef unsigned short bf16_t;
typedef short bf16x8 __attribute__((ext_vector_type(8)));
typedef float f32x4 __attribute__((ext_vector_type(4)));
typedef unsigned u32x4 __attribute__((ext_vector_type(4)));
constexpr int BM = 256, BK = 64, HALF = 128, HTB = HALF * BK * 2  , STAGE_BYTES = 8 * HTB, NXCD = 8, WGM = 8;

__host__ __device__ __forceinline__ int lds_byte(int r, int c) { const int st = (r >> 4) * 2 + (c >> 5), rr = r & 15, cc = c & 31, ob = rr * 64 + cc * 2; return st * 1024 + (ob ^ (((ob >> 9) & 1) << 5)); }
__host__ __device__ __forceinline__ void stage_rc(int b, int& R, int& C) { const int st = b / 1024, sb = b % 1024, swz = sb ^ (((sb >> 9) & 1) << 5); R = (st >> 1) * 16 + swz / 64; C = (st & 1) * 32 + (swz % 64) / 2; }
__host__ __device__ __forceinline__ int perm32(int rho) { const int n = rho >> 4, i = rho & 15; return 8 * (i >> 2) + 4 * n + (i & 3); }

struct Unit { int pm, pn; };
struct Gemm { const bf16_t* A; const bf16_t* Bt; int M, N, K; };

struct StaticOrder {
    int nM, nN, nwg, G, c;
    __host__ __device__ void init(int M, int N, int G_, int c_, int bm = BM) { nM = M / bm; nN = N / BM; nwg = nM * nN; G = G_; c = c_; }
    __host__ __device__ bool next(int i, Unit& u) const {
        const long L = (long)i * G + c; if (L >= nwg) return false;
        int wgid = (int)L; { const int q = nwg / NXCD, r = nwg % NXCD, xcd = wgid % NXCD, off = wgid / NXCD; wgid = (xcd < r ? xcd * (q + 1) : r * (q + 1) + (xcd - r) * q) + off; }
        const int nig = WGM * nN, gid = wgid / nig, fm = gid * WGM, gsz = (nM - fm) < WGM ? (nM - fm) : WGM;
        u.pm = fm + ((wgid % nig) % gsz); u.pn = (wgid % nig) / gsz; return true;
    }
    __device__ __forceinline__ void a_ready(const Unit&) const {}
    __device__ __forceinline__ void done(const Unit&) const {}
};
__device__ __forceinline__ unsigned cvt_pk_bf16(float lo, float hi) { unsigned r; asm volatile("v_cvt_pk_bf16_f32 %0, %1, %2" : "=v"(r) : "v"(lo), "v"(hi)); return r; }

template <class Epi, class Sched, bool ALIGN_EPI = false, bool SP2 = false, int MT = 4  , bool TILED = false  >
__device__ __forceinline__ void gemm_phase(PG8_LAS unsigned char* lds, const Gemm g, const Sched& S, const Epi& E) {
    const int tid = threadIdx.x, wid = __builtin_amdgcn_readfirstlane(tid >> 6), lane = tid & 63, wr = wid >> 2, wc = wid & 3, fr = lane & 15, fq = lane >> 4;
    const int K = g.K, nt = K / BK;
    unsigned voffA[2], voffB[2];
#pragma unroll
    for (int i = 0; i < 2; ++i) { int R, C; stage_rc(tid * 16 + i * 8192, R, C); const int Rb = Epi::PERM ? ((R & ~31) + perm32(R & 31)) : R;
        voffA[i] = (unsigned)(R * (TILED ? BK : K) + C) * 2u; voffB[i] = (unsigned)(Rb * (TILED ? BK : K) + C) * 2u; }
    unsigned voffA3[3]; int ldsA3[3];
#pragma unroll
    for (int p = 0; p < 3; ++p) { const int ch = 8 * p + wid, hh = ch / 12, cb = (ch % 12) * 1024; int R, C; stage_rc(cb + lane * 16, R, C);
        voffA3[p] = (unsigned)((R + 96 * hh) * (TILED ? BK : K) + C) * 2u; ldsA3[p] = hh * HTB + cb; }
    const int LD = TILED ? BK : K;
    const size_t kstepA = TILED ? (size_t)g.M * BK * 2 : (size_t)(BK * 2), kstepB = TILED ? (size_t)g.N * BK * 2 : (size_t)(BK * 2);
    const size_t hstep = (size_t)HALF * LD * 2;
    const size_t tstep = 2 * hstep; const size_t hstepA = (size_t)(32 * MT) * LD * 2, tstepA = 2 * hstepA;
    const unsigned ldsw = (unsigned)wid * 1024u;
    const int aoff = lds_byte(wr * (16 * MT) + fr, fq * 8), boff = lds_byte(wc * 32 + fr, fq * 8);
#define PG8_SA(b, h) (((b) * 2 + (h)) * HTB)
#define PG8_SB(b, h) ((4 + (b) * 2 + (h)) * HTB)
#define PG8_STAGE(bufoff, gbase, voff) do { _Pragma("unroll") for (int _i = 0; _i < 2; ++_i) \
        __builtin_amdgcn_global_load_lds((const unsigned*)((const char*)(gbase) + (voff)[_i]), (PG8_LAS unsigned*)(lds + (bufoff) + ldsw + _i * 8192), 16, 0, 0); } while (0)
#define PG8_STAGE_A3(b, gbase) do { _Pragma("unroll") for (int _p = 0; _p < 3; ++_p) \
        __builtin_amdgcn_global_load_lds((const unsigned*)((const char*)(gbase) + voffA3[_p]), (PG8_LAS unsigned*)(lds + PG8_SA(b, 0) + ldsA3[_p]), 16, 0, 0); } while (0)
#define PG8_LDA(dst, b, h) do { _Pragma("unroll") for (int m = 0; m < MT; ++m) _Pragma("unroll") for (int k = 0; k < 2; ++k) dst[m][k] = *(const PG8_LAS bf16x8*)(lds + PG8_SA(b, h) + aoff + m * 2048 + k * 1024); } while (0)
#define PG8_LDB(dst, b, h) do { _Pragma("unroll") for (int n = 0; n < 2; ++n) _Pragma("unroll") for (int k = 0; k < 2; ++k) dst[n][k] = *(const PG8_LAS bf16x8*)(lds + PG8_SB(b, h) + boff + n * 2048 + k * 1024); } while (0)
#define PG8_MMA(ai, bj, At, Bt) do { __builtin_amdgcn_s_setprio(1); _Pragma("unroll") for (int m = 0; m < MT; ++m) _Pragma("unroll") for (int n = 0; n < 2; ++n) _Pragma("unroll") for (int k = 0; k < 2; ++k) \
        acc[ai][bj][m][n] = __builtin_amdgcn_mfma_f32_16x16x32_bf16(Bt[n][k], At[m][k], acc[ai][bj][m][n], 0, 0, 0); __builtin_amdgcn_s_setprio(0); } while (0)
#define PG8_WAIT_V(n) asm volatile("s_waitcnt vmcnt(" #n ")" ::: "memory")
#define PG8_WAIT_L(n) asm volatile("s_waitcnt lgkmcnt(" #n ")" ::: "memory")
#define PG8_BAR __builtin_amdgcn_s_barrier()
#define PG8_SCHED __builtin_amdgcn_sched_barrier(0)
    Unit cur, nxt; int ui = 0;
    if (!S.next(0, cur)) return;
    f32x4 acc[2][2][MT][2];
#pragma unroll
    for (int a = 0; a < 2; ++a)
#pragma unroll
        for (int b = 0; b < 2; ++b)
#pragma unroll
            for (int m = 0; m < MT; ++m)
#pragma unroll
                for (int n = 0; n < 2; ++n) acc[a][b][m][n] = (f32x4){0.f, 0.f, 0.f, 0.f};
    bf16x8 At[MT][2], B0[2][2], B1[2][2];
    const char* cA = (const char*)g.A + (size_t)cur.pm * tstepA; const char* cB = (const char*)g.Bt + (size_t)cur.pn * tstep;
    S.a_ready(cur);
    if constexpr (SP2) {
        PG8_STAGE(PG8_SB(0, 0), cB, voffB); PG8_STAGE(PG8_SB(0, 1), cB + hstep, voffB);
        if constexpr (MT == 3) { PG8_STAGE_A3(0, cA); if (wr == 1) PG8_BAR; PG8_WAIT_V(1); PG8_BAR; }
        else { PG8_STAGE(PG8_SA(0, 0), cA, voffA); PG8_STAGE(PG8_SA(0, 1), cA + hstepA, voffA); if (wr == 1) PG8_BAR; PG8_WAIT_V(2); PG8_BAR; }
        PG8_STAGE(PG8_SB(1, 0), cB + kstepB, voffB); PG8_STAGE(PG8_SB(1, 1), cB + hstep + kstepB, voffB);
        PG8_WAIT_V(4); PG8_BAR;
    } else {
        PG8_STAGE(PG8_SB(0, 0), cB, voffB); PG8_STAGE(PG8_SA(0, 0), cA, voffA); PG8_STAGE(PG8_SB(0, 1), cB + hstep, voffB); PG8_STAGE(PG8_SA(0, 1), cA + hstepA, voffA);
        if (wr == 1) PG8_BAR;
        PG8_WAIT_V(4); PG8_BAR;
        PG8_STAGE(PG8_SB(1, 0), cB + kstepB, voffB); PG8_STAGE(PG8_SA(1, 0), cA + kstepA, voffA); PG8_STAGE(PG8_SB(1, 1), cB + hstep + kstepB, voffB);
        PG8_WAIT_V(6); PG8_BAR;
    }
    for (;;) {
        const bool has_next = S.next(ui + 1, nxt);
        const char* nA = has_next ? (const char*)g.A + (size_t)nxt.pm * tstepA : cA; const char* nB = has_next ? (const char*)g.Bt + (size_t)nxt.pn * tstep : cB;
        for (int t = 0; t < nt; t += 2) {
            const bool last = (t == nt - 2);
            const char* a1 = cA + (size_t)(t + 1) * kstepA;
            const char* a2 = last ? nA : cA + (size_t)(t + 2) * kstepA; const char* b2 = last ? nB : cB + (size_t)(t + 2) * kstepB;
            const char* a3 = a2 + kstepA; (void)a3; const char* b3 = b2 + kstepB;
            if (last && has_next) S.a_ready(nxt);
            if constexpr (SP2) {
            PG8_LDB(B0, 0, 0); PG8_LDB(B1, 0, 1); PG8_SCHED; PG8_LDA(At, 0, 0);
            if constexpr (MT == 3) { PG8_STAGE_A3(1, a1); PG8_WAIT_V(7); } else { PG8_STAGE(PG8_SA(1, 0), a1, voffA); PG8_STAGE(PG8_SA(1, 1), a1 + hstepA, voffA); PG8_WAIT_V(8); }
            PG8_WAIT_L(0); PG8_BAR; PG8_MMA(0, 0, At, B0); PG8_MMA(0, 1, At, B1); PG8_BAR; PG8_SCHED;
            PG8_LDA(At, 0, 1); PG8_STAGE(PG8_SB(0, 0), b2, voffB); PG8_STAGE(PG8_SB(0, 1), b2 + hstep, voffB);
            if constexpr (MT == 3) PG8_WAIT_V(5); else PG8_WAIT_V(6);
            PG8_WAIT_L(0); PG8_BAR; PG8_MMA(1, 0, At, B0); PG8_MMA(1, 1, At, B1); PG8_BAR; PG8_SCHED;
            PG8_LDB(B0, 1, 0); PG8_LDB(B1, 1, 1); PG8_SCHED; PG8_LDA(At, 1, 0);
            if constexpr (MT == 3) { PG8_STAGE_A3(0, a2); PG8_WAIT_V(7); } else { PG8_STAGE(PG8_SA(0, 0), a2, voffA); PG8_STAGE(PG8_SA(0, 1), a2 + hstepA, voffA); PG8_WAIT_V(8); }
            PG8_WAIT_L(0); PG8_BAR; PG8_MMA(0, 0, At, B0); PG8_MMA(0, 1, At, B1); PG8_BAR; PG8_SCHED;
            PG8_LDA(At, 1, 1); PG8_STAGE(PG8_SB(1, 0), b3, voffB); PG8_STAGE(PG8_SB(1, 1), b3 + hstep, voffB);
            if constexpr (MT == 3) PG8_WAIT_V(5); else PG8_WAIT_V(6);
            PG8_WAIT_L(0); PG8_BAR; PG8_MMA(1, 0, At, B0); PG8_MMA(1, 1, At, B1); PG8_BAR; PG8_SCHED;
            } else {
            PG8_LDB(B0, 0, 0); PG8_SCHED; PG8_LDA(At, 0, 0); PG8_STAGE(PG8_SA(1, 1), a1 + hstepA, voffA);
            PG8_WAIT_L(8); PG8_BAR; PG8_WAIT_L(0); PG8_MMA(0, 0, At, B0); PG8_BAR; PG8_SCHED;
            PG8_LDB(B1, 0, 1); PG8_STAGE(PG8_SB(0, 0), b2, voffB);
            PG8_BAR; PG8_WAIT_L(0); PG8_MMA(0, 1, At, B1); PG8_BAR;
            PG8_LDA(At, 0, 1); PG8_STAGE(PG8_SA(0, 0), a2, voffA);
            PG8_BAR; PG8_WAIT_L(0); PG8_MMA(1, 0, At, B0); PG8_BAR; PG8_SCHED;
            PG8_STAGE(PG8_SB(0, 1), b2 + hstep, voffB);
            PG8_WAIT_V(6); PG8_BAR; PG8_MMA(1, 1, At, B1); PG8_BAR;
            PG8_LDB(B0, 1, 0); PG8_SCHED; PG8_LDA(At, 1, 0); PG8_STAGE(PG8_SA(0, 1), a2 + hstepA, voffA);
            PG8_WAIT_L(8); PG8_BAR; PG8_WAIT_L(0); PG8_MMA(0, 0, At, B0); PG8_BAR; PG8_SCHED;
            PG8_LDB(B1, 1, 1); PG8_STAGE(PG8_SB(1, 0), b3, voffB);
            PG8_BAR; PG8_WAIT_L(0); PG8_MMA(0, 1, At, B1); PG8_BAR;
            PG8_LDA(At, 1, 1); PG8_STAGE(PG8_SA(1, 0), a3, voffA);
            PG8_BAR; PG8_WAIT_L(0); PG8_MMA(1, 0, At, B0); PG8_BAR; PG8_SCHED;
            PG8_STAGE(PG8_SB(1, 1), b3 + hstep, voffB);
            PG8_WAIT_V(6); PG8_BAR; PG8_MMA(1, 1, At, B1); PG8_BAR;
            }
        }
        if constexpr (ALIGN_EPI) { if (wr == 0) PG8_BAR; }
        if constexpr (!Epi::AFTER_DRAIN) { E(acc, cur, wr, wc, fr, fq, ui); S.done(cur); }
        if (!has_next) break;
#pragma unroll
        for (int a = 0; a < 2; ++a)
#pragma unroll
            for (int b = 0; b < 2; ++b)
#pragma unroll
                for (int m = 0; m < MT; ++m)
#pragma unroll
                    for (int n = 0; n < 2; ++n) acc[a][b][m][n] = (f32x4){0.f, 0.f, 0.f, 0.f};
        cur = nxt; cA = nA; cB = nB; ++ui;
        if constexpr (ALIGN_EPI) { if (wr == 1) PG8_BAR; }
    }
    PG8_WAIT_V(0);
    if constexpr (!ALIGN_EPI) { if (wr == 0) PG8_BAR; }
    PG8_BAR;
    if constexpr (Epi::AFTER_DRAIN) { E.fused(acc, cur, wr, wc, fr, fq, lds, wid, lane); S.done(cur); }
#undef PG8_SA
#undef PG8_SB
#undef PG8_STAGE
#undef PG8_LDA
#undef PG8_LDB
#undef PG8_MMA
#undef PG8_WAIT_V
#undef PG8_WAIT_L
#undef PG8_BAR
#undef PG8_SCHED
}
}
#define XB_TMO      128
#define XB_XCNT(j)  (256  + 64 * (j))
#define XB_XSUB(j)  (1280 + 64 * (j))
#define XB_XGEN(j)  (2304 + 64 * (j))
#define XB_TOP      3328
#define XB_TOPGEN   3392
#define XCD_BAR_WORDS 3456
#define XB_SPIN_CAP (1u << 18)

__device__ __forceinline__ unsigned xb_ld(unsigned* p)              { return __hip_atomic_load(p, __ATOMIC_RELAXED, __HIP_MEMORY_SCOPE_AGENT); }
__device__ __forceinline__ unsigned xb_add(unsigned* p, unsigned v) { return __hip_atomic_fetch_add(p, v, __ATOMIC_RELAXED, __HIP_MEMORY_SCOPE_AGENT); }
__device__ __forceinline__ unsigned xb_xcc_id() { return (unsigned)__builtin_amdgcn_s_getreg((3 << 11) | 20) & 0xFu; }
#define XB_SPIN(cond, bar) do { unsigned _sp = 0; while (cond) { __builtin_amdgcn_s_sleep(1); \
    if ((++_sp & 255u) == 0u) { if (xb_ld(&(bar)[XB_TMO])) break; if (_sp > XB_SPIN_CAP) { atomicAdd(&(bar)[XB_TMO], 1u); break; } } } } while (0)

struct XcdBarrier {
    unsigned* bar; unsigned x;
    volatile LAS unsigned* st;
};

__device__ __forceinline__ XcdBarrier xcd_barrier_post(unsigned* bar, volatile LAS unsigned* st) {
    XcdBarrier b; b.bar = bar; b.x = xb_xcc_id(); b.st = st;
    if (threadIdx.x == 0) (void)xb_add(&bar[XB_XCNT(b.x)], 1u);
    return b;
}
__device__ __forceinline__ void xcd_barrier_complete(unsigned* bar, unsigned x, unsigned& nloc, unsigned& nx) {
    const unsigned G = gridDim.x * gridDim.y * gridDim.z;
    unsigned sum, cnt, mine, sp = 0u;
    for (;;) {
        sum = 0u; cnt = 0u; mine = 0u;
#pragma unroll
        for (unsigned j = 0; j < 16; ++j) { const unsigned c = xb_ld(&bar[XB_XCNT(j)]); sum += c; cnt += (c > 0u) ? 1u : 0u; mine = (j == x) ? c : mine; }
        if (sum == G) break;
        __builtin_amdgcn_s_sleep(1);
        if ((++sp & 255u) == 0u) { if (xb_ld(&bar[XB_TMO])) break; if (sp > XB_SPIN_CAP) { atomicAdd(&bar[XB_TMO], 1u); break; } }
    }
    nloc = mine > 0u ? mine : 1u; nx = cnt > 0u ? cnt : 1u;
}

__device__ __forceinline__ void xcd_barrier(const XcdBarrier& b) {
    asm volatile("s_waitcnt vmcnt(0)" ::: "memory");
    __syncthreads();
    if (threadIdx.x == 0) {
        unsigned* bar = b.bar;
        __builtin_amdgcn_s_waitcnt(0);
        unsigned nloc = b.st[0], nx = b.st[1];
        if (nloc == 0u) { xcd_barrier_complete(bar, b.x, nloc, nx); b.st[0] = nloc; b.st[1] = nx; }
        const unsigned old = xb_add(&bar[XB_XSUB(b.x)], 1u);
        const unsigned gen = old / nloc;
        if (old + 1u == (gen + 1u) * nloc) {
            __builtin_amdgcn_fence(__ATOMIC_RELEASE, "agent");
            asm volatile("s_waitcnt vmcnt(0)" ::: "memory");
            const unsigned og = xb_add(&bar[XB_TOP], 1u);
            const unsigned tg = og / nx;
            if (og + 1u == (tg + 1u) * nx) xb_add(&bar[XB_TOPGEN], 1u);
            else XB_SPIN(xb_ld(&bar[XB_TOPGEN]) == tg, bar);
            __builtin_amdgcn_fence(__ATOMIC_ACQUIRE, "agent");
            xb_add(&bar[XB_XGEN(b.x)], 1u);
            asm volatile("s_waitcnt vmcnt(0)" ::: "memory");
        } else {
            XB_SPIN(xb_ld(&bar[XB_XGEN(b.x)]) == gen, bar);
            __builtin_amdgcn_fence(__ATOMIC_ACQUIRE, "agent");
            asm volatile("s_waitcnt vmcnt(0)" ::: "memory");
        }
    }
    __syncthreads();
}
__device__ __forceinline__ int cond_of_panel(int pm) { return pm < 16 ? 0 : 1 + ((pm - 16) >> 2); }
__device__ __forceinline__ f32x4 relu2(f32x4 v) { f32x4 r; r.x = fmaxf(v.x, 0.f); r.y = fmaxf(v.y, 0.f); r.z = fmaxf(v.z, 0.f); r.w = fmaxf(v.w, 0.f); return r * r; }
__device__ __forceinline__ float silu1(float x) { return x * __builtin_amdgcn_rcpf(1.f + __builtin_amdgcn_exp2f(-1.4426950408889634f * x)); }
__device__ __forceinline__ f32x4 silu4(f32x4 v) { f32x4 r; r.x = silu1(v.x); r.y = silu1(v.y); r.z = silu1(v.z); r.w = silu1(v.w); return r; }
__device__ __forceinline__ v4u pack8(f32x4 a, f32x4 b) { v4u w; w.x = cvtpk(a.x, a.y); w.y = cvtpk(a.z, a.w); w.z = cvtpk(b.x, b.y); w.w = cvtpk(b.z, b.w); return w; }
__device__ __forceinline__ f32x4 rope2(f32x4 v, f32x4 cs) { f32x4 r; r.x = v.x * cs.x - v.y * cs.y; r.y = v.y * cs.x + v.x * cs.y; r.z = v.z * cs.z - v.w * cs.w; r.w = v.w * cs.z + v.z * cs.w; return r; }

template <int MT> struct EpiQKV {
    static constexpr bool PERM = true, AFTER_DRAIN = false;
    const float* rowsq; const float* bias; const float* qnp; const float* taba;
    bf16* Q; bf16* KC; bf16* VC; bf16* KL; bf16* VL; float* nck; float* ncv; LAS float* xch;
    __device__ __forceinline__ void operator()(f32x4 (&acc)[2][2][MT][2], const pg8::Unit& u, int wr, int wc, int fr, int fq, int ui) const {
        const int pm = u.pm, pn = u.pn;
        const int rl0 = wr * (16 * MT) + fr, cw = wc * 32 + 8 * fq;
        {
            float rsv[2][MT];
#pragma unroll
            for (int ai = 0; ai < 2; ++ai)
#pragma unroll
                for (int m = 0; m < MT; ++m) rsv[ai][m] = rowsq[pm * (64 * MT) + rl0 + (32 * MT) * ai + 16 * m];
            f32x4 bv[2][2]; int cip = -1;
#pragma unroll
            for (int ai = 0; ai < 2; ++ai)
#pragma unroll
                for (int m = 0; m < MT; ++m) { const int row = pm * (64 * MT) + rl0 + (32 * MT) * ai + 16 * m; const int ci = __builtin_amdgcn_readfirstlane(row < M_CTX ? 0 : 1 + ((row - M_CTX) >> 10));
                    if (ci != cip) { cip = ci; const float* bp = bias + ci * NQKV + pn * 256 + cw;
#pragma unroll
                        for (int bj = 0; bj < 2; ++bj)
#pragma unroll
                            for (int n = 0; n < 2; ++n) bv[bj][n] = *(const f32x4*)(bp + bj * 128 + 4 * n); }
                    const float rs = rsqrtf(rsv[ai][m] * (1.f / DM) + EPS);
#pragma unroll
                    for (int bj = 0; bj < 2; ++bj)
#pragma unroll
                        for (int n = 0; n < 2; ++n) acc[ai][bj][m][n] = acc[ai][bj][m][n] * rs + bv[bj][n]; }
        }
        if (pn < 5) {
            LAS float* X = xch + (ui & 1) * 2048;
#pragma unroll
            for (int ai = 0; ai < 2; ++ai)
#pragma unroll
                for (int m = 0; m < MT; ++m)
#pragma unroll
                    for (int bj = 0; bj < 2; ++bj) { const f32x4 a = acc[ai][bj][m][0], b = acc[ai][bj][m][1];
                        float ss = (a.x * a.x + a.y * a.y) + (a.z * a.z + a.w * a.w) + (b.x * b.x + b.y * b.y) + (b.z * b.z + b.w * b.w);
                        ss += __shfl_xor(ss, 16); ss += __shfl_xor(ss, 32);
                        if (fq == 0) X[(rl0 + (32 * MT) * ai + 16 * m) * 8 + bj * 4 + wc] = ss; }
            f32x4 csv[2][MT][2];
#pragma unroll
            for (int ai = 0; ai < 2; ++ai)
#pragma unroll
                for (int m = 0; m < MT; ++m) { const int row = pm * (64 * MT) + rl0 + (32 * MT) * ai + 16 * m;
                    if (row >= M_CTX) { const float* t = taba + ((size_t)((row - M_CTX) & (S_LAT - 1)) * 64 + (cw >> 1)) * 2; csv[ai][m][0] = *(const f32x4*)t; csv[ai][m][1] = *(const f32x4*)(t + 4); } }
            LDS_WAIT(); __builtin_amdgcn_s_barrier(); asm volatile("" ::: "memory");
            const float* nw = qnp + (pn == 4 ? 128 : 0);
            const f32x4 w0 = *(const f32x4*)(nw + cw), w1 = *(const f32x4*)(nw + cw + 4);
#pragma unroll
            for (int ai = 0; ai < 2; ++ai)
#pragma unroll
                for (int m = 0; m < MT; ++m) {
                    const int rl = rl0 + (32 * MT) * ai + 16 * m, row = pm * (64 * MT) + rl; const bool lat = row >= M_CTX;
                    f32x4 cs0 = {1.f, 0.f, 1.f, 0.f}, cs1 = {1.f, 0.f, 1.f, 0.f}; int pos = 0, lb = 0;
                    if (lat) { pos = (row - M_CTX) & (S_LAT - 1); lb = (row - M_CTX) >> 10; cs0 = csv[ai][m][0]; cs1 = csv[ai][m][1]; }
#pragma unroll
                    for (int bj = 0; bj < 2; ++bj) {
                        const f32x4 p = *(const LAS f32x4*)(X + rl * 8 + bj * 4);
                        const float rn = rsqrtf(((p.x + p.y) + (p.z + p.w)) * (1.f / 128.f) + EPS);
                        f32x4 v0 = acc[ai][bj][m][0] * rn * w0, v1 = acc[ai][bj][m][1] * rn * w1;
                        if (lat) { v0 = rope2(v0, cs0); v1 = rope2(v1, cs1); }
                        const v4u w = pack8(v0, v1);
                        if (pn < 4) *(v4u*)(Q + (size_t)row * DM + pn * 256 + bj * 128 + cw) = w;
                        else if (!lat) {
                            *(v4u*)(KC + (size_t)row * 256 + bj * 128 + cw) = w;
                            const int q0 = cw >> 1, d0 = (q0 >> 5) * 64 + (q0 & 31);
                            float* o = nck + (size_t)row * 256 + bj * 128 + d0;
                            *(f32x4*)o = (f32x4){v0.x, v0.z, v1.x, v1.z}; *(f32x4*)(o + 32) = (f32x4){v0.y, v0.w, v1.y, v1.w};
                        } else *(v4u*)(KL + ((size_t)lb * KVL + PAST + pos) * 256 + bj * 128 + cw) = w;
                    }
                }
        } else {
#pragma unroll
            for (int ai = 0; ai < 2; ++ai)
#pragma unroll
                for (int m = 0; m < MT; ++m) {
                    const int row = pm * (64 * MT) + rl0 + (32 * MT) * ai + 16 * m; const bool lat = row >= M_CTX;
#pragma unroll
                    for (int bj = 0; bj < 2; ++bj) {
                        const f32x4 v0 = acc[ai][bj][m][0], v1 = acc[ai][bj][m][1]; const v4u w = pack8(v0, v1);
                        if (!lat) { *(v4u*)(VC + (size_t)row * 256 + bj * 128 + cw) = w; float* o = ncv + (size_t)row * 256 + bj * 128 + cw; *(f32x4*)o = v0; *(f32x4*)(o + 4) = v1; }
                        else { const int pos = (row - M_CTX) & (S_LAT - 1), lb = (row - M_CTX) >> 10; *(v4u*)(VL + ((size_t)lb * KVL + PAST + pos) * 256 + bj * 128 + cw) = w; }
                    }
                }
        }
    }
};

template <int MT> struct EpiRes {
    static constexpr bool PERM = true, AFTER_DRAIN = false;
    bf16* ab; const float* gs_old;
    const float* gate; const float* gs_new; float* rsq;
    __device__ __forceinline__ void operator()(f32x4 (&acc)[2][2][MT][2], const pg8::Unit& u, int wr, int wc, int fr, int fq, int ui) const {
        const int pm = u.pm, pn = u.pn;
        const int rl0 = wr * (16 * MT) + fr, col0 = pn * 256 + wc * 32 + 8 * fq;
        v4u ao[2][MT][2];
#pragma unroll
        for (int ai = 0; ai < 2; ++ai)
#pragma unroll
            for (int m = 0; m < MT; ++m) { const int row = pm * (64 * MT) + rl0 + (32 * MT) * ai + 16 * m;
#pragma unroll
                for (int bj = 0; bj < 2; ++bj) ao[ai][m][bj] = *(const v4u*)(ab + (size_t)row * DM + col0 + bj * 128); }
        f32x4 gv[2][2], go[2][2], gn[2][2]; int cip = -1;
#pragma unroll
        for (int ai = 0; ai < 2; ++ai)
#pragma unroll
            for (int m = 0; m < MT; ++m) {
                const int row = pm * (64 * MT) + rl0 + (32 * MT) * ai + 16 * m;
                const int ci = __builtin_amdgcn_readfirstlane(row < M_CTX ? 0 : 1 + ((row - M_CTX) >> 10));
                if (ci != cip) { cip = ci;
#pragma unroll
                    for (int bj = 0; bj < 2; ++bj)
#pragma unroll
                        for (int n = 0; n < 2; ++n) { gv[bj][n] = *(const f32x4*)(gate + ci * 6144 + col0 + bj * 128 + 4 * n); go[bj][n] = *(const f32x4*)(gs_old + ci * DM + col0 + bj * 128 + 4 * n); gn[bj][n] = *(const f32x4*)(gs_new + ci * DM + col0 + bj * 128 + 4 * n); } }
                float ss = 0.f;
#pragma unroll
                for (int bj = 0; bj < 2; ++bj) {
                    const v4u w = ao[ai][m][bj];
                    const f32x4 x0 = (f32x4){__builtin_bit_cast(float, w.x << 16), __builtin_bit_cast(float, w.x & 0xffff0000u), __builtin_bit_cast(float, w.y << 16), __builtin_bit_cast(float, w.y & 0xffff0000u)} * go[bj][0];
                    const f32x4 x1 = (f32x4){__builtin_bit_cast(float, w.z << 16), __builtin_bit_cast(float, w.z & 0xffff0000u), __builtin_bit_cast(float, w.w << 16), __builtin_bit_cast(float, w.w & 0xffff0000u)} * go[bj][1];
                    const f32x4 y0 = x0 + gv[bj][0] * acc[ai][bj][m][0], y1 = x1 + gv[bj][1] * acc[ai][bj][m][1];
                    { const f32x4 sq = y0 * y0 + y1 * y1; ss += (sq.x + sq.y) + (sq.z + sq.w); }
                    *(v4u*)(ab + (size_t)row * DM + col0 + bj * 128) = pack8(y0 * gn[bj][0], y1 * gn[bj][1]);
                }
                ss += __shfl_xor(ss, 16); ss += __shfl_xor(ss, 32);
                if (fq == 0) atomicAdd(rsq + row, ss);
            }
    }
};

struct EpiResFinal {
    static constexpr bool PERM = true, AFTER_DRAIN = false;
    const bf16* ab; const float* gs_old; float* yout; const float* gate; const float* fg; float* rsq; unsigned* cnt;
    __device__ __forceinline__ void operator()(f32x4 (&acc)[2][2][3][2], const pg8::Unit& u, int wr, int wc, int fr, int fq, int ui) const {
        constexpr int MT = 3;
        const int pm = u.pm, pn = u.pn;
        const int rl0 = wr * (16 * MT) + fr, col0 = pn * 256 + wc * 32 + 8 * fq;
        v4u ao[2][MT][2];
#pragma unroll
        for (int ai = 0; ai < 2; ++ai)
#pragma unroll
            for (int m = 0; m < MT; ++m) { const int row = pm * (64 * MT) + rl0 + (32 * MT) * ai + 16 * m;
#pragma unroll
                for (int bj = 0; bj < 2; ++bj) ao[ai][m][bj] = *(const v4u*)(ab + (size_t)row * DM + col0 + bj * 128); }
        f32x4 gv[2][2], go[2][2]; int cip = -1;
#pragma unroll
        for (int ai = 0; ai < 2; ++ai)
#pragma unroll
            for (int m = 0; m < MT; ++m) {
                const int row = pm * (64 * MT) + rl0 + (32 * MT) * ai + 16 * m;
                const int ci = __builtin_amdgcn_readfirstlane(row < M_CTX ? 0 : 1 + ((row - M_CTX) >> 10));
                if (ci != cip) { cip = ci;
#pragma unroll
                    for (int bj = 0; bj < 2; ++bj)
#pragma unroll
                        for (int n = 0; n < 2; ++n) { gv[bj][n] = *(const f32x4*)(gate + ci * 6144 + col0 + bj * 128 + 4 * n); go[bj][n] = *(const f32x4*)(gs_old + ci * DM + col0 + bj * 128 + 4 * n); } }
                float ss = 0.f;
#pragma unroll
                for (int bj = 0; bj < 2; ++bj) {
                    const v4u w = ao[ai][m][bj];
                    const f32x4 x0 = (f32x4){__builtin_bit_cast(float, w.x << 16), __builtin_bit_cast(float, w.x & 0xffff0000u), __builtin_bit_cast(float, w.y << 16), __builtin_bit_cast(float, w.y & 0xffff0000u)} * go[bj][0];
                    const f32x4 x1 = (f32x4){__builtin_bit_cast(float, w.z << 16), __builtin_bit_cast(float, w.z & 0xffff0000u), __builtin_bit_cast(float, w.w << 16), __builtin_bit_cast(float, w.w & 0xffff0000u)} * go[bj][1];
                    const f32x4 y0 = x0 + gv[bj][0] * acc[ai][bj][m][0], y1 = x1 + gv[bj][1] * acc[ai][bj][m][1];
                    { const f32x4 sq = y0 * y0 + y1 * y1; ss += (sq.x + sq.y) + (sq.z + sq.w); }
                    acc[ai][bj][m][0] = y0; acc[ai][bj][m][1] = y1;
                }
                ss += __shfl_xor(ss, 16); ss += __shfl_xor(ss, 32);
                if (fq == 0) atomicAdd(rsq + row, ss);
            }
        asm volatile("s_waitcnt vmcnt(0)" ::: "memory");
        unsigned* c = cnt + 64 * pm;
        if ((threadIdx.x & 63) == 0) __hip_atomic_fetch_add(c, 1u, __ATOMIC_RELAXED, __HIP_MEMORY_SCOPE_AGENT);
        if (threadIdx.x < 64) { unsigned sp = 0;
            while ((unsigned)__builtin_amdgcn_readfirstlane(__hip_atomic_load(c, __ATOMIC_RELAXED, __HIP_MEMORY_SCOPE_AGENT)) < 32u) { __builtin_amdgcn_s_sleep(2); if (++sp > (1u << 22)) break; } }
        asm volatile("s_waitcnt vmcnt(0) lgkmcnt(0)" ::: "memory"); __builtin_amdgcn_s_barrier(); asm volatile("" ::: "memory");
        f32x4 fgv[2][2]; float rq[2][MT];
#pragma unroll
        for (int bj = 0; bj < 2; ++bj)
#pragma unroll
            for (int n = 0; n < 2; ++n) fgv[bj][n] = *(const f32x4*)(fg + col0 + bj * 128 + 4 * n);
#pragma unroll
        for (int ai = 0; ai < 2; ++ai)
#pragma unroll
            for (int m = 0; m < MT; ++m) rq[ai][m] = __hip_atomic_load(rsq + pm * (64 * MT) + rl0 + (32 * MT) * ai + 16 * m, __ATOMIC_RELAXED, __HIP_MEMORY_SCOPE_AGENT);
#pragma unroll
        for (int ai = 0; ai < 2; ++ai)
#pragma unroll
            for (int m = 0; m < MT; ++m) {
                const int row = pm * (64 * MT) + rl0 + (32 * MT) * ai + 16 * m;
                const float rs = rsqrtf(rq[ai][m] * (1.f / DM) + EPS);
#pragma unroll
                for (int bj = 0; bj < 2; ++bj) { float* o = yout + (size_t)row * DM + col0 + bj * 128; *(f32x4*)o = acc[ai][bj][m][0] * rs * fgv[bj][0]; *(f32x4*)(o + 4) = acc[ai][bj][m][1] * rs * fgv[bj][1]; }
            }
    }
};

struct EpiMlp1 {
    static constexpr bool PERM = true, AFTER_DRAIN = false;
    const float* rowsq; const float* bias; bf16* H;
#ifdef TS_LO
    unsigned long long* tsb;
#endif
    __device__ __forceinline__ void operator()(f32x4 (&acc)[2][2][4][2], const pg8::Unit& u, int wr, int wc, int fr, int fq, int ui) const {
#ifdef TS_LO
        if (tsb && blockIdx.x == 0 && threadIdx.x == 0) tsb[16 + 2 * ui] = __builtin_amdgcn_s_memrealtime();
#endif
        const int pm = u.pm, pn = u.pn; const int ci = cond_of_panel(pm);
        const int rl0 = wr * 64 + fr, col0 = pn * 256 + wc * 32 + 8 * fq;
        f32x4 bv[2][2];
#pragma unroll
        for (int bj = 0; bj < 2; ++bj)
#pragma unroll
            for (int n = 0; n < 2; ++n) bv[bj][n] = *(const f32x4*)(bias + ci * FFD + col0 + bj * 128 + 4 * n);
        float rsv[2][4];
#pragma unroll
        for (int ai = 0; ai < 2; ++ai)
#pragma unroll
            for (int m = 0; m < 4; ++m) rsv[ai][m] = rowsq[pm * 256 + rl0 + 128 * ai + 16 * m];
#pragma unroll
        for (int ai = 0; ai < 2; ++ai)
#pragma unroll
            for (int m = 0; m < 4; ++m) {
                const int row = pm * 256 + rl0 + 128 * ai + 16 * m; const float rs = rsqrtf(rsv[ai][m] * (1.f / DM) + EPS);
#pragma unroll
                for (int bj = 0; bj < 2; ++bj)
                    *(v4u*)(H + ((size_t)((col0 + bj * 128) >> 6) * MTOK + row) * 64 + ((col0 + bj * 128) & 63)) = pack8(relu2(acc[ai][bj][m][0] * rs + bv[bj][0]), relu2(acc[ai][bj][m][1] * rs + bv[bj][1]));
            }
#ifdef TS_LO
        if (tsb && blockIdx.x == 0 && threadIdx.x == 0) tsb[17 + 2 * ui] = __builtin_amdgcn_s_memrealtime();
#endif
    }
};

struct EpiProj {
    static constexpr bool PERM = true, AFTER_DRAIN = false;
    const float* rowsq; const float* bias; const float* tabr; bf16* RQ; bf16* RK; bf16* RV; bf16* RG;
    __device__ __forceinline__ void operator()(f32x4 (&acc)[2][2][4][2], const pg8::Unit& u, int wr, int wc, int fr, int fq, int ui) const {
        const int pm = u.pm, pn = u.pn; const bool lat = pm >= 16; const int ci = cond_of_panel(pm);
        const int rl0 = wr * 64 + fr, cw = wc * 32 + 8 * fq;
        f32x4 bv[2][2];
#pragma unroll
        for (int bj = 0; bj < 2; ++bj)
#pragma unroll
            for (int n = 0; n < 2; ++n) bv[bj][n] = *(const f32x4*)(bias + ci * NRETP + pn * 256 + bj * 128 + cw + 4 * n);
        bf16* dst = RQ + (size_t)(pn >> 2) * ((size_t)MTOK * DM) + (pn & 3) * 256 + cw;
        const float qs = pn < 4 ? 0.0625f : 1.f;
        float rsv[2][4];
#pragma unroll
        for (int ai = 0; ai < 2; ++ai)
#pragma unroll
            for (int m = 0; m < 4; ++m) rsv[ai][m] = rowsq[pm * 256 + rl0 + 128 * ai + 16 * m];
        const bool rope = pn < 8 && lat;
        f32x4 csr[2][2], cca[2], ccb[2];
        const float* tcol = tabr + ((size_t)fr * 128 + 64 + (cw >> 1)) * 2;
        if (rope) {
            const int pbase = (pm * 256 - M_CTX) & (S_LAT - 1);
#pragma unroll
            for (int ai = 0; ai < 2; ++ai) { const float* t = tabr + ((size_t)(pbase + 128 * ai + 64 * wr) * 128 + (cw >> 1)) * 2; csr[ai][0] = *(const f32x4*)t; csr[ai][1] = *(const f32x4*)(t + 4); }
            cca[0] = *(const f32x4*)tcol; cca[1] = *(const f32x4*)(tcol + 4);
        }
#define PROJ_FRAG(m, CC) do { _Pragma("unroll") for (int ai = 0; ai < 2; ++ai) { \
            const int row = pm * 256 + rl0 + 128 * ai + 16 * (m); const float rs = rsqrtf(rsv[ai][m] * (1.f / DM) + EPS); \
            _Pragma("unroll") for (int bj = 0; bj < 2; ++bj) { \
                f32x4 v0 = acc[ai][bj][m][0] * rs + bv[bj][0], v1 = acc[ai][bj][m][1] * rs + bv[bj][1]; \
                if (pn < 8) { if (lat) { v0 = rope2(v0, bj ? CC[0] : csr[ai][0]); v1 = rope2(v1, bj ? CC[1] : csr[ai][1]); } v0 = v0 * qs; v1 = v1 * qs; } \
                else if (pn >= 12) { v0 = silu4(v0); v1 = silu4(v1); } \
                *(v4u*)(dst + (size_t)row * DM + bj * 128) = pack8(v0, v1); } } } while (0)
#define PROJ_NEXT(m, CC) do { if (rope) { CC[0] = *(const f32x4*)(tcol + (size_t)(16 * (m)) * 256); CC[1] = *(const f32x4*)(tcol + (size_t)(16 * (m)) * 256 + 4); } } while (0)
        PROJ_NEXT(1, ccb); PROJ_FRAG(0, cca);
        PROJ_NEXT(2, cca); PROJ_FRAG(1, ccb);
        PROJ_NEXT(3, ccb); PROJ_FRAG(2, cca);
        PROJ_FRAG(3, ccb);
#undef PROJ_FRAG
#undef PROJ_NEXT
    }
};
__device__ __forceinline__ float wave_sum(float v) {
#pragma unroll
    for (int o = 1; o < 64; o <<= 1) v += __shfl_xor(v, o);
    return v;
}
template <int MAP> __device__ __forceinline__ int rowmap(int n) {
    if (MAP == 1) return n < 1280 ? (n & ~127) + posA(n & 127) : n;
    if (MAP == 2) return n < 2048 ? (n & ~255) + posR(n & 255) : n;
    return n;
}
template <int MAP, bool BIAS = false, bool TILED = false  > __device__ __forceinline__ void p0_transpose_item(const float* W, int K, int N, bf16* WT, LAS float* scr, int item, int lane, const float* sh = nullptr, float* bout = nullptr, LAS float* shs = nullptr) {
    const int nblk = N / 64, kb = item / nblk, nb = item % nblk, k0 = 64 * kb, n0 = 64 * nb;
    const int kr = lane >> 4, ng = lane & 15;
    f32x4 w[16];
    const float* wp = W + (size_t)(k0 + kr) * N + n0 + 4 * ng;
#pragma unroll
    for (int i = 0; i < 16; ++i) w[i] = __builtin_nontemporal_load((const f32x4*)(wp + (size_t)(4 * i) * N));
#pragma unroll
    for (int i = 0; i < 16; ++i) { const int k = 4 * i + kr; *(LAS f32x4*)(scr + k * 64 + 4 * (ng ^ (k >> 3))) = w[i]; }
    LDS_WAIT(); asm volatile("" ::: "memory");
#pragma unroll
    for (int it = 0; it < 8; ++it) { const int nn = it * 8 + (lane >> 3), c = lane & 7; const LAS float* s = scr + (8 * c) * 64 + 4 * ((nn >> 2) ^ c) + (nn & 3);
        v4u o; o.x = pk2(s[0 * 64], s[1 * 64]); o.y = pk2(s[2 * 64], s[3 * 64]); o.z = pk2(s[4 * 64], s[5 * 64]); o.w = pk2(s[6 * 64], s[7 * 64]);
        *(GAS v4u*)(WT + (TILED ? ((size_t)kb * N + rowmap<MAP>(n0 + nn)) * 64 + 8 * c : (size_t)rowmap<MAP>(n0 + nn) * K + k0 + 8 * c)) = o; }
    if (BIAS) {
        LAS float* ssh = shs;
#pragma unroll
        for (int ci = 0; ci < NCOND; ++ci) ssh[ci * 64 + lane] = sh[ci * 6144 + k0 + lane];
        LDS_WAIT(); asm volatile("" ::: "memory");
        float b[NCOND];
#pragma unroll
        for (int ci = 0; ci < NCOND; ++ci) b[ci] = 0.f;
#pragma unroll 2
        for (int k = 0; k < 64; k += 4) {
            float w[4];
#pragma unroll
            for (int j = 0; j < 4; ++j) w[j] = scr[(k + j) * 64 + 4 * ((lane >> 2) ^ ((k + j) >> 3)) + (lane & 3)];
#pragma unroll
            for (int ci = 0; ci < NCOND; ++ci) { const f32x4 sv = *(const LAS f32x4*)(ssh + ci * 64 + k); b[ci] += sv.x * w[0] + sv.y * w[1] + sv.z * w[2] + sv.w * w[3]; }
        }
        const int col = rowmap<MAP>(n0 + lane);
#pragma unroll
        for (int ci = 0; ci < NCOND; ++ci) atomicAdd(bout + (size_t)ci * N + col, b[ci]);
    }
    LDS_WAIT(); asm volatile("" ::: "memory");
}
__device__ __forceinline__ void p0_mod_item(const float* W, int n0, int k0, const float* c_ctx, const float* c_lat, float* out, const float* addb, LAS float* scr, int lane, unsigned long long* tsx = nullptr) {
    constexpr int N = 6144;
#pragma unroll
    for (int ci = 0; ci < NCOND; ++ci) { const float x = (ci == 0 ? c_ctx : c_lat + (ci - 1) * DM)[k0 + (lane & 31)]; scr[ci * 64 + lane] = x / (1.f + expf(-x)); }
    LDS_WAIT(); asm volatile("" ::: "memory");
    if (tsx && lane == 0) atomicMax(tsx + 44, (unsigned long long)__builtin_amdgcn_s_memrealtime());
    f32x4 a[NCOND];
#pragma unroll
    for (int ci = 0; ci < NCOND; ++ci) a[ci] = (f32x4){0.f, 0.f, 0.f, 0.f};
    const float* wp = W + (size_t)k0 * N + n0 + 4 * lane;
    int kend = 32; asm volatile("" : "+s"(kend));
#pragma unroll 1
    for (int kk = 0; kk < kend; kk += 32) {
        f32x4 w[32];
#pragma unroll
        for (int j = 0; j < 32; ++j) w[j] = __builtin_nontemporal_load((const f32x4*)(wp + (size_t)(kk + j) * N));
#pragma unroll
        for (int j4 = 0; j4 < 8; ++j4)
#pragma unroll
            for (int ci = 0; ci < NCOND; ++ci) { const f32x4 s = *(const LAS f32x4*)(scr + ci * 64 + kk + 4 * j4);
                a[ci] = a[ci] + w[4 * j4] * s.x + w[4 * j4 + 1] * s.y + w[4 * j4 + 2] * s.z + w[4 * j4 + 3] * s.w; }
    }
    if (tsx && lane == 0) atomicMax(tsx + 45, (unsigned long long)__builtin_amdgcn_s_memrealtime());
    LAS float* tr = scr + 1024;
#pragma unroll
    for (int ci = 0; ci < NCOND; ++ci) { f32x4 r = a[ci]; if (k0 == 0) r = r + *(const f32x4*)(addb + n0 + 4 * lane); *(LAS f32x4*)(tr + ci * 256 + 4 * lane) = r; }
    LDS_WAIT(); asm volatile("" ::: "memory");
#pragma unroll
    for (int ci = 0; ci < NCOND; ++ci)
#pragma unroll
        for (int j = 0; j < 4; ++j) atomicAdd(out + (size_t)ci * N + n0 + 64 * j + lane, tr[ci * 256 + 64 * j + lane]);
    LDS_WAIT(); asm volatile("" ::: "memory");
}
__device__ __forceinline__ void p1_bias_item(const bf16* WT, int n0, const float* sh, float* out, int ostride, int lane) {
    v4u w[4][2];
#pragma unroll
    for (int r = 0; r < 4; ++r)
#pragma unroll
        for (int h = 0; h < 2; ++h) w[r][h] = *(const v4u*)(WT + (size_t)(n0 + r) * DM + 512 * h + 8 * lane);
    float acc[4][NCOND];
#pragma unroll
    for (int r = 0; r < 4; ++r)
#pragma unroll
        for (int ci = 0; ci < NCOND; ++ci) acc[r][ci] = 0.f;
#pragma unroll
    for (int h = 0; h < 2; ++h)
#pragma unroll
        for (int ci = 0; ci < NCOND; ++ci) {
            const f32x4 s0 = *(const f32x4*)(sh + (size_t)ci * 6144 + 512 * h + 8 * lane), s1 = *(const f32x4*)(sh + (size_t)ci * 6144 + 512 * h + 8 * lane + 4);
#pragma unroll
            for (int r = 0; r < 4; ++r) { const v4u u = w[r][h];
                acc[r][ci] += __builtin_bit_cast(float, u.x << 16) * s0.x + __builtin_bit_cast(float, u.x & 0xffff0000u) * s0.y + __builtin_bit_cast(float, u.y << 16) * s0.z + __builtin_bit_cast(float, u.y & 0xffff0000u) * s0.w
                            + __builtin_bit_cast(float, u.z << 16) * s1.x + __builtin_bit_cast(float, u.z & 0xffff0000u) * s1.y + __builtin_bit_cast(float, u.w << 16) * s1.z + __builtin_bit_cast(float, u.w & 0xffff0000u) * s1.w; }
        }
#pragma unroll
    for (int r = 0; r < 4; ++r)
#pragma unroll
        for (int ci = 0; ci < NCOND; ++ci) { const float v = wave_sum(acc[r][ci]); if (lane == r * NCOND + ci) out[(size_t)ci * ostride + n0 + r] = v; }
}
namespace att {
constexpr int D = 128, NW = 8, QBLK = 32, KVBLK = 64;
constexpr float SCALE = 0.088388347648318440f;
constexpr float THR = 8.f;
constexpr int LDQ = 1024, LDK = 256, LDO = 1024;
constexpr size_t SHM_V = KVBLK * D * 2, SHM_K = KVBLK * D * 2, SHM_ATTN = 2 * SHM_V + 2 * SHM_K + NW * 64 * 4;
#define KSWZ(row, colB) ((row) * 256 + ((colB) ^ (((row) & 7) << 4)))
#define SBAR() __builtin_amdgcn_sched_barrier(0)
__device__ __forceinline__ int crow(int r, int hi) { return (r & 3) + 8 * (r >> 2) + 4 * hi; }
__device__ __forceinline__ void partialSM(f32x16& p0, f32x16& p1, float& m_reg, float& mn, float& alpha) {
  constexpr float C = SCALE * 1.4426950408889634f;
  float pmax = p0[0]; for (int r = 1; r < 16; ++r) pmax = fmaxf(pmax, p0[r]); for (int r = 0; r < 16; ++r) pmax = fmaxf(pmax, p1[r]);
  { auto rr = __builtin_amdgcn_permlane32_swap(__float_as_uint(pmax), __float_as_uint(pmax), false, false);
    pmax = fmaxf(__uint_as_float(rr[0]), __uint_as_float(rr[1])); }
  if (__builtin_expect(__all(pmax - m_reg <= THR / SCALE), 1)) { mn = m_reg; alpha = 1.f; }
  else { mn = fmaxf(m_reg, pmax); alpha = __builtin_amdgcn_exp2f((m_reg - mn) * C); m_reg = mn; }
  float mnC = -mn * C;
  for (int r = 0; r < 16; ++r) p0[r] = fmaf(p0[r], C, mnC); for (int r = 0; r < 16; ++r) p1[r] = fmaf(p1[r], C, mnC);
  for (int r = 0; r < 16; ++r) p0[r] = __builtin_amdgcn_exp2f(p0[r]);
}
__device__ __forceinline__ void finishSM(f32x16& p0, f32x16& p1, float alpha, float& l_reg, bf16x8& pa0, bf16x8& pa1, bf16x8& pa2, bf16x8& pa3) {
  for (int r = 0; r < 16; ++r) p1[r] = __builtin_amdgcn_exp2f(p1[r]);
  float ps = 0; for (int r = 0; r < 16; ++r) ps += p0[r]; for (int r = 0; r < 16; ++r) ps += p1[r];
  { auto rr = __builtin_amdgcn_permlane32_swap(__float_as_uint(ps), __float_as_uint(ps), false, false);
    ps = __uint_as_float(rr[0]) + __uint_as_float(rr[1]); }
  l_reg = l_reg * alpha + ps;
#define PK4(P, BASE, OUT) do { unsigned a0 = cvtpk(P[BASE + 0], P[BASE + 1]), a1 = cvtpk(P[BASE + 2], P[BASE + 3]);   \
    unsigned b0 = cvtpk(P[BASE + 4], P[BASE + 5]), b1 = cvtpk(P[BASE + 6], P[BASE + 7]);                              \
    auto r0 = __builtin_amdgcn_permlane32_swap(a0, b0, false, false); auto r1 = __builtin_amdgcn_permlane32_swap(a1, b1, false, false); \
    v4u w = {r0[0], r1[0], r0[1], r1[1]}; OUT = *reinterpret_cast<bf16x8*>(&w); } while (0)
  PK4(p0, 0, pa0); PK4(p0, 8, pa1); PK4(p1, 0, pa2); PK4(p1, 8, pa3);
#undef PK4
}
__device__ __forceinline__ void qkt(f32x16& p0, f32x16& p1, const bf16* Ks, const bf16x8* qr, int r32, int hi) {
  p0 = f32x16{}; p1 = f32x16{};
  for (int d0 = 0; d0 < 8; ++d0) { int cb = (d0 * 16 + hi * 8) * 2;
    bf16x8 b0 = *reinterpret_cast<const bf16x8*>((const char*)Ks + KSWZ(r32, cb));
    bf16x8 b1 = *reinterpret_cast<const bf16x8*>((const char*)Ks + KSWZ(32 + r32, cb));
    p0 = __builtin_amdgcn_mfma_f32_32x32x16_bf16(b0, qr[d0], p0, 0, 0, 0);
    p1 = __builtin_amdgcn_mfma_f32_32x32x16_bf16(b1, qr[d0], p1, 0, 0, 0); }
}
__device__ __forceinline__ int v_st(int k, int c) { const int kk = (k & ~0xC) | ((k & 4) << 1) | ((k & 8) >> 1); return ((kk >> 3) * 4 + (c >> 5)) * 512 + ((kk & 7) * 32 + (c & 31)) * 2; }
__device__ __forceinline__ int v_rd_base(int lane) { return ((lane & 3) << 3) | (((lane >> 2) & 3) << 6) | (((lane >> 4) & 1) << 5) | (((lane >> 5) & 1) << 8); }
constexpr int v_rd_off(int d0, int ks, int half) { return d0 * 512 + ks * 4096 + half * 2048; }
template <int OFF> __device__ __forceinline__ s16x4 tr_read(int vb) {
  s16x4 r; asm volatile("ds_read_b64_tr_b16 %0, %1 offset:%2" : "=&v"(r) : "v"(vb), "i"(OFF) : "memory"); return r;
}
#define ATT_PK(L, H) (bf16x8){L[0], L[1], L[2], L[3], H[0], H[1], H[2], H[3]}
template <int D0> __device__ __forceinline__ void pv_one(f32x16& od, int vb, bf16x8 pa0, bf16x8 pa1, bf16x8 pa2, bf16x8 pa3) {
  const s16x4 l0 = tr_read<v_rd_off(D0, 0, 0)>(vb), h0 = tr_read<v_rd_off(D0, 0, 1)>(vb), l1 = tr_read<v_rd_off(D0, 1, 0)>(vb), h1 = tr_read<v_rd_off(D0, 1, 1)>(vb);
  const s16x4 l2 = tr_read<v_rd_off(D0, 2, 0)>(vb), h2 = tr_read<v_rd_off(D0, 2, 1)>(vb), l3 = tr_read<v_rd_off(D0, 3, 0)>(vb), h3 = tr_read<v_rd_off(D0, 3, 1)>(vb);
  asm volatile("s_waitcnt lgkmcnt(0)" ::: "memory"); SBAR();
  od = __builtin_amdgcn_mfma_f32_32x32x16_bf16(pa0, ATT_PK(l0, h0), od, 0, 0, 0);
  od = __builtin_amdgcn_mfma_f32_32x32x16_bf16(pa1, ATT_PK(l1, h1), od, 0, 0, 0);
  od = __builtin_amdgcn_mfma_f32_32x32x16_bf16(pa2, ATT_PK(l2, h2), od, 0, 0, 0);
  od = __builtin_amdgcn_mfma_f32_32x32x16_bf16(pa3, ATT_PK(l3, h3), od, 0, 0, 0);
}
__device__ __forceinline__ void pv_d0(f32x16* o, int vb, bf16x8 pa0, bf16x8 pa1, bf16x8 pa2, bf16x8 pa3) {
  pv_one<0>(o[0], vb, pa0, pa1, pa2, pa3); pv_one<1>(o[1], vb, pa0, pa1, pa2, pa3); pv_one<2>(o[2], vb, pa0, pa1, pa2, pa3); pv_one<3>(o[3], vb, pa0, pa1, pa2, pa3);
}
__device__ __forceinline__ void attn_unit(const bf16* Qb, const bf16* __restrict__ Kh, const bf16* __restrict__ Vh, bf16* Ob, int seq, char* lds) {
  const int tid = threadIdx.x, wid = tid >> 6, lane = tid & 63, r32 = lane & 31, hi = lane >> 5;
  bf16* V_lds = (bf16*)lds; bf16* K_lds = (bf16*)(lds + 2 * SHM_V);
  float* ws = (float*)(lds + 2 * SHM_V + 2 * SHM_K) + wid * 64; float* li_l = ws; float* al_l = ws + 32;
  float m_reg = -1e30f, l_reg = 0; f32x16 o[4] = {}; bf16x8 qr[8];
  const bf16* Qw = Qb + (long)(wid * QBLK + r32) * LDQ + hi * 8;
#pragma unroll
  for (int d0 = 0; d0 < 8; ++d0) qr[d0] = *reinterpret_cast<const bf16x8*>(Qw + d0 * 16);
  const int sr = tid >> 4, sc = (tid & 15) * 8, vst0 = v_st(sr, sc), vst1 = v_st(32 + sr, sc);
  const int vb0 = (int)(uintptr_t)V_lds + v_rd_base(lane);
  struct { bf16x8 vs0, vs1, ks0, ks1; } sr_[2];
#define SLOAD(i, k0) do { sr_[i].vs0 = *reinterpret_cast<const bf16x8*>(&Vh[(long)((k0) + sr) * LDK + sc]); sr_[i].vs1 = *reinterpret_cast<const bf16x8*>(&Vh[(long)((k0) + 32 + sr) * LDK + sc]); \
    sr_[i].ks0 = *reinterpret_cast<const bf16x8*>(&Kh[(long)((k0) + sr) * LDK + sc]); sr_[i].ks1 = *reinterpret_cast<const bf16x8*>(&Kh[(long)((k0) + 32 + sr) * LDK + sc]); } while (0)
#define SWRITE(b, i) do { *(bf16x8*)((char*)V_lds + (b) * SHM_V + vst0) = sr_[i].vs0;          \
    *(bf16x8*)((char*)V_lds + (b) * SHM_V + vst1) = sr_[i].vs1; int kc = sc * 2;               \
    *(bf16x8*)((char*)K_lds + (b) * SHM_K + KSWZ(sr, kc)) = sr_[i].ks0;                       \
    *(bf16x8*)((char*)K_lds + (b) * SHM_K + KSWZ(32 + sr, kc)) = sr_[i].ks1; } while (0)
#define SWAIT() asm volatile("s_waitcnt vmcnt(4)" ::: "memory")
#define RESC(a) do { if (__any((a) < 1.f)) { if (hi == 0) al_l[r32] = (a); asm volatile("s_waitcnt lgkmcnt(0)" ::: "memory"); \
    for (int d = 0; d < 4; ++d) for (int r = 0; r < 16; ++r) o[d][r] *= al_l[crow(r, hi)]; } } while (0)
  f32x16 pA0, pA1, pB0, pB1; float mnA, mnB, alA, alB; bf16x8 pa0, pa1, pa2, pa3; const int NT = seq / KVBLK;
  constexpr int SE = 0, SO = 1;
  SLOAD(SE, 0); SLOAD(SO, KVBLK);
  SWAIT(); SWRITE(0, SE); __syncthreads();
  qkt(pA0, pA1, K_lds, qr, r32, hi); partialSM(pA0, pA1, m_reg, mnA, alA);
  if (2 < NT) SLOAD(SE, 2 * KVBLK);
  if (2 < NT) SWAIT(); else asm volatile("s_waitcnt vmcnt(0)" ::: "memory");
  SWRITE(1, SO); __syncthreads();
  for (int j = 1; j + 1 < NT; j += 2) {
    SBAR(); qkt(pB0, pB1, (bf16*)((char*)K_lds + SHM_K), qr, r32, hi);
    finishSM(pA0, pA1, alA, l_reg, pa0, pa1, pa2, pa3); SBAR();
    SLOAD(SO, (j + 2) * KVBLK); SBAR();
    pv_d0(o, vb0, pa0, pa1, pa2, pa3); partialSM(pB0, pB1, m_reg, mnB, alB);
    __syncthreads(); SWAIT(); SWRITE(0, SE);
    RESC(alB); __syncthreads();
    SBAR(); qkt(pA0, pA1, K_lds, qr, r32, hi);
    finishSM(pB0, pB1, alB, l_reg, pa0, pa1, pa2, pa3); SBAR();
    if (j + 3 < NT) SLOAD(SE, (j + 3) * KVBLK); SBAR();
    pv_d0(o, vb0 + (int)SHM_V, pa0, pa1, pa2, pa3); partialSM(pA0, pA1, m_reg, mnA, alA);
    __syncthreads(); SWAIT(); SWRITE(1, SO);
    RESC(alA); __syncthreads();
  }
  SBAR(); qkt(pB0, pB1, (bf16*)((char*)K_lds + SHM_K), qr, r32, hi);
  finishSM(pA0, pA1, alA, l_reg, pa0, pa1, pa2, pa3); SBAR();
  pv_d0(o, vb0, pa0, pa1, pa2, pa3); partialSM(pB0, pB1, m_reg, mnB, alB);
  __syncthreads(); RESC(alB);
  finishSM(pB0, pB1, alB, l_reg, pa0, pa1, pa2, pa3); SBAR();
  pv_d0(o, vb0 + (int)SHM_V, pa0, pa1, pa2, pa3);
  if (hi == 0) li_l[r32] = l_reg; asm volatile("s_waitcnt lgkmcnt(0)" ::: "memory");
  float rli[16];
#pragma unroll
  for (int r = 0; r < 16; ++r) rli[r] = __builtin_amdgcn_rcpf(li_l[crow(r, hi)]);
  __syncthreads();
  { unsigned short* stg = (unsigned short*)(lds + wid * 8192);
#pragma unroll
    for (int r = 0; r < 16; ++r) { const int orow = crow(r, hi);
#pragma unroll
      for (int d0 = 0; d0 < 4; d0 += 2) { const unsigned w = cvtpk(o[d0][r] * rli[r], o[d0 + 1][r] * rli[r]); stg[orow * 128 + d0 * 32 + r32] = (unsigned short)w; stg[orow * 128 + (d0 + 1) * 32 + r32] = (unsigned short)(w >> 16); } }
    asm volatile("s_waitcnt lgkmcnt(0)" ::: "memory");
    bf16* Ow = Ob + (long)(wid * QBLK) * LDO;
#pragma unroll
    for (int i = 0; i < 8; ++i) { const int row = i * 4 + (lane >> 4), ch = lane & 15; const v4u v = *(const v4u*)(stg + row * 128 + ch * 8); *(v4u*)(Ow + (long)row * LDO + ch * 8) = v; } }
  __syncthreads();
#undef SLOAD
#undef SWRITE
#undef SWAIT
#undef RESC
}
#undef KSWZ
#undef SBAR
}
namespace ret {
using att::v_st; using att::v_rd_base; using att::v_rd_off; using att::tr_read; using att::crow;
#define SBAR() __builtin_amdgcn_sched_barrier(0)
#define RET_PK(L, H) (bf16x8){L[0], L[1], L[2], L[3], H[0], H[1], H[2], H[3]}
__device__ __forceinline__ float log_sigmoid(float x) { return fminf(x, 0.f) - log1pf(expf(-fabsf(x))); }
__device__ __forceinline__ bf16x8 scale8(bf16x8 v, float s) {
    const v4u u = __builtin_bit_cast(v4u, v); v4u r;
    r.x = cvtpk(__builtin_bit_cast(float, u.x << 16) * s, __builtin_bit_cast(float, u.x & 0xffff0000u) * s);
    r.y = cvtpk(__builtin_bit_cast(float, u.y << 16) * s, __builtin_bit_cast(float, u.y & 0xffff0000u) * s);
    r.z = cvtpk(__builtin_bit_cast(float, u.z << 16) * s, __builtin_bit_cast(float, u.z & 0xffff0000u) * s);
    r.w = cvtpk(__builtin_bit_cast(float, u.w << 16) * s, __builtin_bit_cast(float, u.w & 0xffff0000u) * s);
    return __builtin_bit_cast(bf16x8, r);
}
constexpr int CH = 128;
constexpr int A_BUF = 49152;

template <int KS> __device__ __forceinline__ void retA_ks(f32x16 (&acc)[2][2], int kb, int vb) {
    const s16x4 a0l = tr_read<v_rd_off(0, KS, 0)>(kb), a0h = tr_read<v_rd_off(0, KS, 1)>(kb), a1l = tr_read<v_rd_off(1, KS, 0)>(kb), a1h = tr_read<v_rd_off(1, KS, 1)>(kb);
    const s16x4 b0l = tr_read<v_rd_off(0, KS, 0)>(vb), b0h = tr_read<v_rd_off(0, KS, 1)>(vb), b1l = tr_read<v_rd_off(1, KS, 0)>(vb), b1h = tr_read<v_rd_off(1, KS, 1)>(vb);
    asm volatile("s_waitcnt lgkmcnt(0)" ::: "memory"); SBAR();
    const bf16x8 a0 = RET_PK(a0l, a0h), a1 = RET_PK(a1l, a1h), b0 = RET_PK(b0l, b0h), b1 = RET_PK(b1l, b1h);
    acc[0][0] = __builtin_amdgcn_mfma_f32_32x32x16_bf16(a0, b0, acc[0][0], 0, 0, 0);
    acc[0][1] = __builtin_amdgcn_mfma_f32_32x32x16_bf16(a0, b1, acc[0][1], 0, 0, 0);
    acc[1][0] = __builtin_amdgcn_mfma_f32_32x32x16_bf16(a1, b0, acc[1][0], 0, 0, 0);
    acc[1][1] = __builtin_amdgcn_mfma_f32_32x32x16_bf16(a1, b1, acc[1][1], 0, 0, 0);
}

#ifdef TS_LO
#define RA_TS(i) do { if (R.tsb && blockIdx.x == 0 && threadIdx.x == 0 && lat) R.tsb[i] = __builtin_amdgcn_s_memrealtime(); } while (0)
#else
#define RA_TS(i) do { } while (0)
#endif
struct RetAArgs {
#ifdef TS_LO
    unsigned long long* tsb;
#endif
    unsigned char* ws; float* out; const float* state_in; const float* decay_logit; };
__device__ __forceinline__ void retA_unit(const RetAArgs& R, int lat, int b, int h, int dir, int dvh, LAS unsigned char* lds) {
    const int tid = threadIdx.x, wid = tid >> 6, lane = tid & 63, r32 = lane & 31, hi = lane >> 5;
    const int wq = wid >> 1, wd = wid & 1;
    const int nc = lat ? 8 : 2; const long row0 = lat ? M_CTX + (long)b * S_LAT : (long)b * S_CTX;
    const float lg = log_sigmoid(R.decay_logit[dir * 4 + h]); const float cdec = expf(lg * (float)CH);
    f32x16 acc[2][2];
    if (lat) {
        const float* si = R.state_in + ((size_t)((b * 2 + dir) * 4 + h) * 256) * 256 + dvh * 128 + wd * 64 + r32;
#pragma unroll
        for (int ia = 0; ia < 2; ++ia)
#pragma unroll
            for (int r = 0; r < 16; ++r) { const int d = dimR(wq * 64 + ia * 32 + crow(r, hi));
                acc[ia][0][r] = __builtin_nontemporal_load(si + (size_t)d * 256); acc[ia][1][r] = __builtin_nontemporal_load(si + (size_t)d * 256 + 32); }
    } else {
#pragma unroll
        for (int ia = 0; ia < 2; ++ia)
#pragma unroll
            for (int ib = 0; ib < 2; ++ib) acc[ia][ib] = f32x16{};
    }
    const int sr = tid >> 4, sc = (tid & 15) * 8, st0 = v_st(sr, sc), st1 = v_st(32 + sr, sc);
    const int lbase = (int)(uintptr_t)lds;
    const int kb0 = lbase + (wq >> 1) * 16384 + (wq & 1) * 1024 + v_rd_base(lane);
    const int vb0 = lbase + 32768 + wd * 1024 + v_rd_base(lane);
    const bf16* Kg = ((const bf16*)(R.ws + WS_RK)) + row0 * DM + h * 256 + sc; const bf16* Vg = ((const bf16*)(R.ws + WS_RV)) + row0 * DM + h * 256 + dvh * 128 + sc;
    bf16x8 ka0, ka1, ka2, ka3, va0, va1, kb0_, kb1_, kb2_, kb3_, vb0_, vb1_;
#define RA_LOAD(K0, K1, K2, K3, V0, V1, tok0) do { int sr_ = sr; asm volatile("" : "+v"(sr_)); const bf16* kp = Kg + (long)((tok0) + sr_) * DM; const bf16* vp = Vg + (long)((tok0) + sr_) * DM; \
        K0 = *(const bf16x8*)kp; K1 = *(const bf16x8*)(kp + 32 * DM); K2 = *(const bf16x8*)(kp + 128); K3 = *(const bf16x8*)(kp + 32 * DM + 128); \
        V0 = *(const bf16x8*)vp; V1 = *(const bf16x8*)(vp + 32 * DM); } while (0)
#define RA_WRITE(K0, K1, K2, K3, V0, V1, buf, jl0) do { LAS unsigned char* B_ = lds + (buf) * A_BUF; \
        const float e0 = dir ? (float)((jl0) + sr) : (float)(CH - 1 - (jl0) - sr), e1 = dir ? e0 + 32.f : e0 - 32.f; \
        *(LAS bf16x8*)(B_ + st0) = K0; *(LAS bf16x8*)(B_ + st1) = K1; *(LAS bf16x8*)(B_ + 16384 + st0) = K2; *(LAS bf16x8*)(B_ + 16384 + st1) = K3; \
        *(LAS bf16x8*)(B_ + 32768 + st0) = scale8(V0, __builtin_amdgcn_exp2f(lg2 * e0)); *(LAS bf16x8*)(B_ + 32768 + st1) = scale8(V1, __builtin_amdgcn_exp2f(lg2 * e1)); } while (0)
#define RA_TOK(s_) (((dir ? nc - 1 - ((s_) >> 1) : ((s_) >> 1)) * CH) + ((s_) & 1) * 64)
#define RA_STORE_STATE(cc_) do { bf16* st = lat ? (dir ? ((bf16*)(R.out)) : ((bf16*)(R.ws + WS_STLF))) + ((size_t)((b * 4 + h) * 8 + (cc_)) << 16) : ((bf16*)(R.ws + WS_STC)) + ((size_t)((b * 4 + h) * 2 + dir) << 16); \
        int lo_ = (wq * 64 + 4 * hi) * 256 + dvh * 128 + wd * 64 + r32; asm volatile("" : "+v"(lo_));     \
        _Pragma("unroll") for (int ia = 0; ia < 2; ++ia) _Pragma("unroll") for (int ib = 0; ib < 2; ++ib) { bf16* sp = st + (unsigned)(lo_ + ia * 32 * 256 + ib * 32); \
            _Pragma("unroll") for (int r = 0; r < 16; r += 2) { const unsigned w_ = cvtpk(acc[ia][ib][r], acc[ia][ib][r + 1]); sp[((r & 3) + 8 * (r >> 2)) * 256] = (bf16)w_; sp[(((r + 1) & 3) + 8 * ((r + 1) >> 2)) * 256] = (bf16)(w_ >> 16); } } } while (0)
    const float lg2 = lg * 1.4426950408889634f;
    const int nsteps = lat ? nc - 1 : nc;
    const int nsub = nsteps * 2;
    RA_LOAD(ka0, ka1, ka2, ka3, va0, va1, RA_TOK(0)); RA_LOAD(kb0_, kb1_, kb2_, kb3_, vb0_, vb1_, RA_TOK(1));
    RA_WRITE(ka0, ka1, ka2, ka3, va0, va1, 0, 0);
    __syncthreads();
#define RA_STEP(s, LK0, LK1, LK2, LK3, LV0, LV1, WK0, WK1, WK2, WK3, WV0, WV1) do { \
        if ((s) + 2 < nsub) RA_LOAD(LK0, LK1, LK2, LK3, LV0, LV1, RA_TOK((s) + 2)); \
        if (((s) & 1) == 0) { const int c_ = (s) >> 1, cc_ = dir ? nc - 1 - c_ : c_; RA_TS(22 + 2 * c_); if (lat || c_ > 0) RA_STORE_STATE(cc_); RA_TS(23 + 2 * c_); \
            _Pragma("unroll") for (int ia = 0; ia < 2; ++ia) _Pragma("unroll") for (int ib = 0; ib < 2; ++ib) acc[ia][ib] = acc[ia][ib] * cdec; } \
        const int bo = ((s) & 1) * A_BUF; \
        retA_ks<0>(acc, kb0 + bo, vb0 + bo); retA_ks<1>(acc, kb0 + bo, vb0 + bo); retA_ks<2>(acc, kb0 + bo, vb0 + bo); retA_ks<3>(acc, kb0 + bo, vb0 + bo); \
        if ((s) + 1 < nsub) RA_WRITE(WK0, WK1, WK2, WK3, WV0, WV1, ((s) + 1) & 1, (((s) + 1) & 1) * 64); \
        __syncthreads(); } while (0)
    for (int s = 0; s < nsub; s += 2) {
        RA_STEP(s, ka0, ka1, ka2, ka3, va0, va1, kb0_, kb1_, kb2_, kb3_, vb0_, vb1_);
        RA_STEP(s + 1, kb0_, kb1_, kb2_, kb3_, vb0_, vb1_, ka0, ka1, ka2, ka3, va0, va1);
    }
    if (lat) {
        const int cc = dir ? 0 : nc - 1; RA_STORE_STATE(cc);
    } else {
        float* so = (R.out + OUT_NST_F) + ((size_t)((b * 2 + dir) * 4 + h) * 256) * 256 + dvh * 128 + wd * 64 + r32;
#pragma unroll
        for (int ia = 0; ia < 2; ++ia)
#pragma unroll
            for (int r = 0; r < 16; ++r) { const int d = dimR(wq * 64 + ia * 32 + crow(r, hi));
                so[(size_t)d * 256] = acc[ia][0][r]; so[(size_t)d * 256 + 32] = acc[ia][1][r]; }
    }
#undef RA_LOAD
#undef RA_WRITE
#undef RA_TOK
#undef RA_STORE_STATE
#undef RA_STEP
}

__device__ __forceinline__ int img_off(int row, int chunk) { return row * 256 + ((chunk ^ (row & 15)) << 4); }
__device__ __forceinline__ void stage_img(LAS unsigned char* img, const bf16* src, int nrows, int ld, int tid) {
    const int tr = tid >> 4, ch = tid & 15;
    for (int r = tr; r < nrows; r += 32) *(LAS bf16x8*)(img + img_off(r, ch)) = *(const bf16x8*)(src + (size_t)r * ld + ch * 8);
}
__device__ __forceinline__ bf16x8 frag(const LAS unsigned char* img, int rb, int ks, int r32, int hi) { return *(const LAS bf16x8*)(img + img_off(rb + r32, 2 * ks + hi)); }

#ifdef TS_LO
#define RB_TS(i) do { if (R.tsb && blockIdx.x == 0 && threadIdx.x == 0 && lat) R.tsb[i] = __builtin_amdgcn_s_memrealtime(); } while (0)
#else
#define RB_TS(i) do { } while (0)
#endif
struct RetBArgs {
#ifdef TS_LO
    unsigned long long* tsb;
#endif
    unsigned char* ws; float* out; const float* decay_logit; const float* gn_w; };
__device__ __forceinline__ void retB_unit(const RetBArgs& R, int lat, int b, int h, int cc, LAS unsigned char* lds) {
    const int tid = threadIdx.x, wid = tid >> 6, lane = tid & 63, r32 = lane & 31, hi = lane >> 5;
    const int wr2 = wid >> 2, wc4 = wid & 3;
    const int nc = lat ? 8 : 2; const long row0 = (lat ? M_CTX + (long)b * S_LAT : (long)b * S_CTX) + cc * CH;
    const float lgf = log_sigmoid(R.decay_logit[h]), lgb = log_sigmoid(R.decay_logit[4 + h]);
    LAS unsigned char* RA = lds; LAS unsigned char* RB = lds + 65536;
    LAS float* rtab = (LAS float*)(lds + XCH_OFF);
    const bool has_f = lat || cc > 0, has_b = lat || cc < nc - 1;
    if (tid < CH) { const float i = (float)tid; const float df = expf(lgf * (i + 1.f)), db = expf(lgb * ((float)CH - i));
        rtab[tid] = has_b ? df / db : 1.f; rtab[CH + tid] = has_b ? db : df; }
    const bf16* Qg = ((const bf16*)(R.ws + WS_RQ)) + row0 * DM + h * 256; const bf16* Kg = ((const bf16*)(R.ws + WS_RK)) + row0 * DM + h * 256;
    RB_TS(16);
    {
        const int tr = tid >> 4, ch = tid & 15; bf16x8 gq[8], gk[8];
#pragma unroll
        for (int i = 0; i < 4; ++i) { const size_t o = (size_t)(tr + 32 * i) * DM + ch * 8; gq[i] = *(const bf16x8*)(Qg + o); gq[4 + i] = *(const bf16x8*)(Qg + o + 128); gk[i] = *(const bf16x8*)(Kg + o); gk[4 + i] = *(const bf16x8*)(Kg + o + 128); }
#pragma unroll
        for (int i = 0; i < 4; ++i) { const int off = img_off(tr + 32 * i, ch);
            *(LAS bf16x8*)(RA + off) = gq[i]; *(LAS bf16x8*)(RA + 32768 + off) = gq[4 + i]; *(LAS bf16x8*)(RB + off) = gk[i]; *(LAS bf16x8*)(RB + 32768 + off) = gk[4 + i]; }
    }
    __syncthreads();
    RB_TS(17);
    const bf16* sfp = lat ? ((bf16*)(R.ws + WS_STLF)) + ((size_t)((b * 4 + h) * 8 + cc) << 16) : ((bf16*)(R.ws + WS_STC)) + ((size_t)((b * 4 + h) * 2 + 0) << 16);
    const bf16* sbp = lat ? ((bf16*)(R.out)) + ((size_t)((b * 4 + h) * 8 + cc) << 16) : ((bf16*)(R.ws + WS_STC)) + ((size_t)((b * 4 + h) * 2 + 1) << 16);
    const bf16* Vgp = ((const bf16*)(R.ws + WS_RV)) + row0 * DM + h * 256;
    const int sr = tid >> 4, sc = (tid & 15) * 8, st0 = v_st(sr, sc), st1 = v_st(32 + sr, sc);
    bf16x8 f0, f1, f2, f3, f4, f5, f6, f7;
#define RB_ACTIVE(st) ((st) < 2 ? has_f : (st) < 4 ? has_b : true)
#define RB_FETCH(st) do { const bf16* src_ = (st) == 0 ? sfp : (st) == 1 ? sfp + 128 * 256 : (st) == 2 ? sbp : (st) == 3 ? sbp + 128 * 256 : Vgp; const long ld_ = (st) == 4 ? DM : 256; \
        int sr_ = sr; asm volatile("" : "+v"(sr_)); const bf16* p_ = src_ + (long)sr_ * ld_ + sc; \
        f0 = *(const bf16x8*)p_; f1 = *(const bf16x8*)(p_ + 32 * ld_); f2 = *(const bf16x8*)(p_ + 128); f3 = *(const bf16x8*)(p_ + 32 * ld_ + 128); \
        f4 = *(const bf16x8*)(p_ + 64 * ld_); f5 = *(const bf16x8*)(p_ + 96 * ld_); f6 = *(const bf16x8*)(p_ + 64 * ld_ + 128); f7 = *(const bf16x8*)(p_ + 96 * ld_ + 128); } while (0)
#define RB_COMMIT() do { *(LAS bf16x8*)(RB + st0) = f0; *(LAS bf16x8*)(RB + st1) = f1; *(LAS bf16x8*)(RB + 16384 + st0) = f2; *(LAS bf16x8*)(RB + 16384 + st1) = f3; \
        *(LAS bf16x8*)(RB + 32768 + st0) = f4; *(LAS bf16x8*)(RB + 32768 + st1) = f5; *(LAS bf16x8*)(RB + 49152 + st0) = f6; *(LAS bf16x8*)(RB + 49152 + st1) = f7; } while (0)
    int cur = has_f ? 0 : 2;
    RB_FETCH(cur);
    unsigned pk[2][8];
    {
        f32x16 p0 = f32x16{}, p1 = f32x16{}; const int ibq = wid & 3, jb0 = (wid >> 2) * 2;
#pragma unroll
        for (int ks = 0; ks < 16; ++ks) { const int im = (ks >> 3) * 32768, k8 = ks & 7;
            const bf16x8 qf = frag(RA + im, ibq * 32, k8, r32, hi), kf0 = frag(RB + im, jb0 * 32, k8, r32, hi), kf1 = frag(RB + im, jb0 * 32 + 32, k8, r32, hi);
            p0 = __builtin_amdgcn_mfma_f32_32x32x16_bf16(kf0, qf, p0, 0, 0, 0);
            p1 = __builtin_amdgcn_mfma_f32_32x32x16_bf16(kf1, qf, p1, 0, 0, 0); }
        const int i = ibq * 32 + r32; const float lgf2 = lgf * 1.4426950408889634f, lgb2 = lgb * 1.4426950408889634f;
#pragma unroll
        for (int r = 0; r < 16; ++r) { const int j0 = jb0 * 32 + crow(r, hi), j1 = j0 + 32;
            p0[r] *= __builtin_amdgcn_exp2f((i >= j0) ? lgf2 * (float)(i - j0) : lgb2 * (float)(j0 - i));
            p1[r] *= __builtin_amdgcn_exp2f((i >= j1) ? lgf2 * (float)(i - j1) : lgb2 * (float)(j1 - i)); }
#pragma unroll
        for (int g = 0; g < 4; ++g) { pk[0][2 * g] = cvtpk(p0[4 * g], p0[4 * g + 1]); pk[0][2 * g + 1] = cvtpk(p0[4 * g + 2], p0[4 * g + 3]);
            pk[1][2 * g] = cvtpk(p1[4 * g], p1[4 * g + 1]); pk[1][2 * g + 1] = cvtpk(p1[4 * g + 2], p1[4 * g + 3]); }
    }
    __syncthreads();
    RB_TS(18);
    f32x16 acc[2][2];
#pragma unroll
    for (int ia = 0; ia < 2; ++ia)
#pragma unroll
        for (int ib = 0; ib < 2; ++ib) acc[ia][ib] = f32x16{};
    RB_COMMIT();
    __syncthreads();
#define RB_SCALE(tb) do { _Pragma("unroll") for (int ia = 0; ia < 2; ++ia) _Pragma("unroll") for (int r = 0; r < 16; ++r) { const float s_ = (tb)[wr2 * 64 + ia * 32 + crow(r, hi)]; acc[ia][0][r] *= s_; acc[ia][1][r] *= s_; } } while (0)
    const int vb = (int)(uintptr_t)RB + (wc4 >> 1) * 16384 + (wc4 & 1) * 1024 + v_rd_base(lane);
#define RB_MM(Aimg, KB, KS) do { const int vbb = vb + (KB) * 32768; \
        const s16x4 b0l = tr_read<v_rd_off(0, KS, 0)>(vbb), b0h = tr_read<v_rd_off(0, KS, 1)>(vbb), b1l = tr_read<v_rd_off(1, KS, 0)>(vbb), b1h = tr_read<v_rd_off(1, KS, 1)>(vbb); \
        const bf16x8 a0 = frag(Aimg, wr2 * 64, (KB) * 4 + (KS), r32, hi), a1 = frag(Aimg, wr2 * 64 + 32, (KB) * 4 + (KS), r32, hi); \
        asm volatile("s_waitcnt lgkmcnt(0)" ::: "memory"); SBAR(); \
        const bf16x8 b0 = RET_PK(b0l, b0h), b1 = RET_PK(b1l, b1h); \
        acc[0][0] = __builtin_amdgcn_mfma_f32_32x32x16_bf16(a0, b0, acc[0][0], 0, 0, 0); acc[0][1] = __builtin_amdgcn_mfma_f32_32x32x16_bf16(a0, b1, acc[0][1], 0, 0, 0); \
        acc[1][0] = __builtin_amdgcn_mfma_f32_32x32x16_bf16(a1, b0, acc[1][0], 0, 0, 0); acc[1][1] = __builtin_amdgcn_mfma_f32_32x32x16_bf16(a1, b1, acc[1][1], 0, 0, 0); } while (0)
#pragma unroll 1
    while (cur < 5) {
        int nx = cur + 1; if (nx == 2 && !has_b) nx = 4;
        if (nx < 5) RB_FETCH(nx);
        if (cur == 4) RB_SCALE(rtab + CH);
        const LAS unsigned char* Aimg = RA + ((cur < 4 && (cur & 1)) ? 32768 : 0);
        RB_MM(Aimg, 0, 0); RB_MM(Aimg, 0, 1); RB_MM(Aimg, 0, 2); RB_MM(Aimg, 0, 3); RB_MM(Aimg, 1, 0); RB_MM(Aimg, 1, 1); RB_MM(Aimg, 1, 2); RB_MM(Aimg, 1, 3);
        if (cur == 1) RB_SCALE(rtab);
        __syncthreads();
        if (nx < 5) RB_COMMIT();
        if (nx == 4) {
            const int ibq = wid & 3, jb0 = (wid >> 2) * 2, i = ibq * 32 + r32;
#pragma unroll
            for (int t = 0; t < 2; ++t)
#pragma unroll
                for (int g = 0; g < 4; ++g) { const int j0 = (jb0 + t) * 32 + 8 * g + 4 * hi;
                    *(LAS v2u*)(RA + img_off(i, j0 >> 3) + (j0 & 7) * 2) = (v2u){pk[t][2 * g], pk[t][2 * g + 1]}; }
        }
        __syncthreads();
        cur = nx;
    }
#undef RB_ACTIVE
#undef RB_FETCH
#undef RB_COMMIT
#undef RB_MM
    RB_TS(19);
    {
        LAS float* OL = (LAS float*)lds;
#pragma unroll
        for (int ia = 0; ia < 2; ++ia)
#pragma unroll
            for (int ib = 0; ib < 2; ++ib)
#pragma unroll
                for (int r = 0; r < 16; ++r) OL[(wr2 * 64 + ia * 32 + crow(r, hi)) * 256 + wc4 * 64 + ib * 32 + r32] = acc[ia][ib][r];
        __syncthreads();
        const int row = tid >> 2, qd = tid & 3; const LAS float* orow = OL + row * 256 + qd * 64;
        const bf16* gp = ((const bf16*)(R.ws + WS_RG)) + (row0 + row) * DM + h * 256 + qd * 64; bf16* op = ((bf16*)(R.ws + WS_RO)) + (row0 + row) * DM + h * 256 + qd * 64; const float* gw = R.gn_w + h * 256 + qd * 64;
        v4u gg[8]; f32x4 gw0[8], gw1[8];
#pragma unroll
        for (int k = 0; k < 8; ++k) { const int kk = (k + lane) & 7; gg[k] = *(const v4u*)(gp + 8 * kk); gw0[k] = *(const f32x4*)(gw + 8 * kk); gw1[k] = *(const f32x4*)(gw + 8 * kk + 4); }
        float s = 0.f;
#pragma unroll
        for (int k = 0; k < 16; ++k) { const f32x4 x = *(const LAS f32x4*)(orow + 4 * ((k + lane) & 15)); s += (x.x + x.y) + (x.z + x.w); }
        s += __shfl_xor(s, 1); s += __shfl_xor(s, 2);
        const float mu = s * (1.f / 256.f); float q = 0.f;
#pragma unroll
        for (int k = 0; k < 16; ++k) { const f32x4 x = *(const LAS f32x4*)(orow + 4 * ((k + lane) & 15)) - mu; q += (x.x * x.x + x.y * x.y) + (x.z * x.z + x.w * x.w); }
        q += __shfl_xor(q, 1); q += __shfl_xor(q, 2);
        const float rstd = rsqrtf(q * (1.f / 256.f) + EPS);
#pragma unroll
        for (int k = 0; k < 8; ++k) { const int kk = (k + lane) & 7;
            const f32x4 x0 = (*(const LAS f32x4*)(orow + 8 * kk) - mu) * rstd * gw0[k], x1 = (*(const LAS f32x4*)(orow + 8 * kk + 4) - mu) * rstd * gw1[k];
            const v4u g = gg[k];
            v4u w; w.x = cvtpk(x0.x * __builtin_bit_cast(float, g.x << 16), x0.y * __builtin_bit_cast(float, g.x & 0xffff0000u)); w.y = cvtpk(x0.z * __builtin_bit_cast(float, g.y << 16), x0.w * __builtin_bit_cast(float, g.y & 0xffff0000u));
            w.z = cvtpk(x1.x * __builtin_bit_cast(float, g.z << 16), x1.y * __builtin_bit_cast(float, g.z & 0xffff0000u)); w.w = cvtpk(x1.z * __builtin_bit_cast(float, g.w << 16), x1.w * __builtin_bit_cast(float, g.w & 0xffff0000u));
            *(v4u*)(op + 8 * kk) = w; }
    }
    __syncthreads();
    RB_TS(20);
#undef RB_SCALE
}
#undef SBAR
#undef RET_PK
}
#ifndef MK_N_LAUNCHES
#define MK_N_LAUNCHES 1
#endif
constexpr int N_PHASES = 13;
struct Args {
    const float* x_prompt; const float* x_sample; const float* cache_k; const float* cache_v; const float* state_ret; const float* c; const float* c_ctx;
    const float* w_mod; const float* b_mod; const float* norm_g; const float* attn_w_qkv; const float* attn_q_norm; const float* attn_k_norm; const float* attn_w_o;
    const float* ret_w_qkvg; const float* ret_decay_logit; const float* ret_gn_w; const float* ret_w_o; const float* mlp_w1; const float* mlp_w2; const float* final_norm_g;
    float* out; unsigned char* ws; int ph_lo, ph_hi;
};
constexpr size_t OUT_NCK = (size_t)MTOK * DM, OUT_NCV = OUT_NCK + (size_t)M_CTX * 256, OUT_NST = OUT_NCV + (size_t)M_CTX * 256;

__global__ void __launch_bounds__(NWAVES * 64, 2) fwd_kernel(Args a) {
    extern __shared__ __attribute__((aligned(16))) unsigned char lds_raw[];
    LAS unsigned char* lds = (LAS unsigned char*)lds_raw;
    volatile LAS unsigned* MISC = (volatile LAS unsigned*)(lds + MISC_OFF);
    const int tid = threadIdx.x, lane = tid & 63, lane0 = lane, wave = __builtin_amdgcn_readfirstlane(tid >> 6);
    const int G = gridDim.x, bx = blockIdx.x, vcu = (G % 8 == 0) ? (bx % 8) * (G / 8) + bx / 8 : bx;
#define WSP (a.ws)
#define ctl ((gu32*)(WSP + WS_CTL))
#define MOD ((float*)(WSP + CTL_MODACC))
#define BQKV ((float*)(WSP + CTL_BIAS))
#define B1_0 (BQKV + NCOND * NQKV)
#define BPROJ (B1_0 + NCOND * FFD)
#define B1_1 (BPROJ + NCOND * FFD)
#define ROWSQ ((float*)(WSP + CTL_ROWSQ))
#define TABA ((float*)(WSP + WS_SMALL + SM_TABA))
#define TABR ((float*)(WSP + WS_SMALL + SM_TABR))
#define GS ((float*)(WSP + WS_SMALL + SM_GS))
#define RGS ((float*)(WSP + WS_SMALL + SM_RGS))
#define QNP ((float*)(WSP + WS_SMALL + SM_QNP))
#define WQKV_t ((bf16*)(WSP + WS_WQKV))
#define WO_t ((bf16*)(WSP + WS_WO))
#define W1_t0 ((bf16*)(WSP + WS_W1_0))
#define W2_t0 ((bf16*)(WSP + WS_W2_0))
#define RETW_t ((bf16*)(WSP + WS_RETW))
#define RETWO_t ((bf16*)(WSP + WS_RETWO))
#define W1_t1 ((bf16*)(WSP + WS_W1_1))
#define W2_t1 ((bf16*)(WSP + WS_W2_1))
#define AB ((bf16*)(WSP + WS_A))
#define QB ((bf16*)(WSP + WS_Q))
#define KC ((bf16*)(WSP + WS_KC))
#define VC ((bf16*)(WSP + WS_VC))
#define KL ((bf16*)(WSP + WS_KL))
#define VL ((bf16*)(WSP + WS_VL))
#define HFF ((bf16*)(WSP + WS_HFF))
#define RQ ((bf16*)(WSP + WS_RQ))
#define RK ((bf16*)(WSP + WS_RK))
#define RV ((bf16*)(WSP + WS_RV))
#define RG ((bf16*)(WSP + WS_RG))
#define RO ((bf16*)(WSP + WS_RO))
#define STC ((bf16*)(WSP + WS_STC))
#define STLF ((bf16*)(WSP + WS_STLF))
#define STLB ((bf16*)(a.out))
#define XR (a.out)
    for (int u = tid; u < (XCH_OFF - LDSCTL_OFF) / 4; u += NWAVES * 64) ((LAS unsigned*)(lds + LDSCTL_OFF))[u] = 0u;
    __syncthreads();
    XcdBarrier bar; bar.bar = (unsigned*)(ctl + CW_BAR); bar.x = 0; bar.st = nullptr;
    if (MK_N_LAUNCHES == 1) bar = xcd_barrier_post((unsigned*)(ctl + CW_BAR), MISC + 8);
    const int lo = a.ph_lo, hi = a.ph_hi;
#define IN(k) (lo <= (k) && (k) < hi)
#ifdef TS_LO
#define TSB ((unsigned long long*)(a.ws + 1536 * 1024))
#define SEAM(k) do { if (IN(k) && IN((k) + 1)) xcd_barrier(bar); if (((k) + 1 == TS_LO || (k) + 1 == TS_HI) && blockIdx.x == 0 && threadIdx.x == 0) { ((unsigned long long*)(a.ws + 1536 * 1024))[(k) + 1] = __builtin_amdgcn_s_memrealtime(); ((unsigned long long*)(a.ws + 1536 * 1024))[32 + (k) + 1] = __builtin_amdgcn_s_memtime(); } } while (0)
    if (TS_LO == 0 && bx == 0 && tid == 0) { TSB[0] = __builtin_amdgcn_s_memrealtime(); TSB[32] = __builtin_amdgcn_s_memtime(); }
#else
#define SEAM(k) do { if (IN(k) && IN((k) + 1)) xcd_barrier(bar); } while (0)
#endif
    const int gw = vcu * NWAVES + wave, NGW = G * NWAVES;
    const int gwi = wave * G + vcu;
    const int gt = (vcu * NWAVES + wave) * 64 + lane, NGT = NGW * 64;
    LAS float* scr = (LAS float*)(lds + wave * 16384);
    LAS float* shs = (LAS float*)(lds + XCH_OFF) + wave * 576;

    if (IN(0)) {
        constexpr int I_MOD = 2 * 24 * 32, I_QKV = 16 * 24, I_WO = 16 * 16, I_W2 = 64 * 16, I_W1 = 16 * 64, NIT = I_MOD + I_QKV + 2 * I_WO + I_W2;
        for (int it = gwi; it < NIT; it += NGW) { int r = it; int lane = lane0; asm volatile("" : "+v"(lane));
            if (r < I_MOD) { const int L = r / 768, q = r % 768; p0_mod_item(a.w_mod + (size_t)L * DM * 6144, (q / 32) * 256, (q % 32) * 32, a.c_ctx, a.c, MOD + (size_t)L * NCOND * 6144, a.b_mod + L * 6144, scr, lane); continue; } r -= I_MOD;
            if (r < I_QKV) { p0_transpose_item<1>(a.attn_w_qkv, DM, NQKV, WQKV_t, scr, r, lane); continue; } r -= I_QKV;
            if (r < I_WO) { p0_transpose_item<0>(a.attn_w_o, DM, DM, WO_t, scr, r, lane); continue; } r -= I_WO;
            if (r < I_WO) { p0_transpose_item<0>(a.ret_w_o, DM, DM, RETWO_t, scr, r, lane); continue; } r -= I_WO;
            p0_transpose_item<0, false, true>(a.mlp_w2, FFD, DM, W2_t0, scr, r, lane);
        }
        for (int i = gt; i < 2 * NB_LAT * PAST * 32; i += NGT) { const int isv = i >= NB_LAT * PAST * 32, j = isv ? i - NB_LAT * PAST * 32 : i;
            const int c8 = j & 31, t = (j >> 5) & (PAST - 1), b = j >> 14; const float* src = (isv ? a.cache_v : a.cache_k) + ((size_t)(b * PAST + t) * 256);
            float v[8];
#pragma unroll
            for (int e = 0; e < 8; ++e) { const int col = c8 * 8 + e; v[e] = __builtin_nontemporal_load(src + (isv ? col : (col & ~127) + dimA(col & 127))); }
            v4u w; w.x = pk2(v[0], v[1]); w.y = pk2(v[2], v[3]); w.z = pk2(v[4], v[5]); w.w = pk2(v[6], v[7]);
            *(v4u*)((isv ? VL : KL) + ((size_t)b * KVL + t) * 256 + c8 * 8) = w; }
        for (int i = gt; i < S_LAT * 64; i += NGT) { const int pos = i >> 6, q = i & 63, hf = q >> 5, ii = q & 31;
            const float fr = exp2f(-(float)ii * (13.287712379549449f / 32.f)); const float ang = (float)(hf ? (pos & 63) : (pos >> 6)) * fr; float sn, cs; sincosf(ang, &sn, &cs);
            TABA[2 * i] = cs; TABA[2 * i + 1] = sn; }
        for (int i = gt; i < S_LAT * 128; i += NGT) { const int pos = i >> 7, q = i & 127, hf = q >> 6, ii = q & 63;
            const float fr = exp2f(-(float)ii * (13.287712379549449f / 64.f)); const float ang = (float)(hf ? (pos & 63) : (pos >> 6)) * fr; float sn, cs; sincosf(ang, &sn, &cs);
            TABR[2 * i] = cs; TABR[2 * i + 1] = sn; }
        if (gt < 256) QNP[gt] = (gt < 128 ? a.attn_q_norm : a.attn_k_norm)[dimA(gt & 127)];
    }
    SEAM(0);
    if (IN(1)) {
        for (int i = gt; i < 2 * 2 * NCOND * DM; i += NGT) { const int k = i & (DM - 1), ci = (i >> 10) % NCOND, wh = (i / (NCOND * DM)) & 1, L = i / (2 * NCOND * DM);
            const float gsv = a.norm_g[(L * 2 + wh) * DM + k] * (1.f + MOD[((size_t)L * NCOND + ci) * 6144 + (wh ? 4 : 1) * DM + k]); GS[i] = gsv; RGS[i] = 1.f / gsv; }
        for (int it = gwi; it < 384; it += NGW) { int lane = lane0; asm volatile("" : "+v"(lane)); p1_bias_item(WQKV_t, it * 4, MOD, BQKV, NQKV, lane); }
        {
            constexpr int RPW = 6; static_assert(MTOK % RPW == 0, "rows per wave");
            f32x4 x[RPW][4];
#pragma unroll
            for (int t = 0; t < RPW; ++t) { const int m = gw + NGW * t; const float* xrow = m < M_CTX ? a.x_prompt + (size_t)m * DM : a.x_sample + (size_t)(m - M_CTX) * DM;
                if (m < MTOK) {
#pragma unroll
                    for (int j = 0; j < 4; ++j) x[t][j] = __builtin_nontemporal_load((const f32x4*)(xrow + 4 * lane + 256 * j)); } }
#pragma unroll
            for (int t = 0; t < RPW; ++t) { const int m = gw + NGW * t; if (m < MTOK) { const int ci = m < M_CTX ? 0 : 1 + ((m - M_CTX) >> 10); const float* sc = MOD + (size_t)ci * 6144 + DM; float s = 0.f;
#pragma unroll
                for (int j = 0; j < 4; ++j) { const int k = 4 * lane + 256 * j; const f32x4 xv = x[t][j], g = *(const f32x4*)(a.norm_g + k), sv = *(const f32x4*)(sc + k);
                    s += (xv.x * xv.x + xv.y * xv.y) + (xv.z * xv.z + xv.w * xv.w); const f32x4 y = xv * g * (sv + 1.f);
                    v2u w; w.x = cvtpk(y.x, y.y); w.y = cvtpk(y.z, y.w); *(v2u*)(AB + (size_t)m * DM + k) = w; }
                s = wave_sum(s); if (lane == 0) ROWSQ[m] = s; } }
        }
    }
    SEAM(1);
    if (IN(2)) {
        pg8::Gemm g{AB, WQKV_t, MTOK, NQKV, DM}; pg8::StaticOrder S; S.init(MTOK, NQKV, G, bx, 192);
        EpiQKV<3> E{ROWSQ, BQKV, QNP, TABA, QB, KC, VC, KL, VL, a.out + OUT_NCK, a.out + OUT_NCV, (LAS float*)(lds + XCH_OFF)};
        pg8::gemm_phase<EpiQKV<3>, pg8::StaticOrder, true, true, 3>(lds, g, S, E);
        if (bx >= 384 - G) {
            constexpr int NIT = 16 * 64;
            const int nid = 2 * G - 384, sw = wave * nid + (bx - (384 - G)), NSW = nid * NWAVES;
            for (int it = sw; it < NIT; it += NSW) { int lane = lane0; asm volatile("" : "+v"(lane));
                p0_transpose_item<0, true>(a.mlp_w1, DM, FFD, W1_t0, scr, it, lane, MOD + 3 * DM, B1_0, shs); }
            for (int it = sw; it < NIT; it += NSW) { int lane = lane0; asm volatile("" : "+v"(lane));
                p0_transpose_item<0>(a.mlp_w1 + (size_t)DM * FFD, DM, FFD, W1_t1, scr, it, lane); }
            for (int it = sw; it < NIT; it += NSW) { int lane = lane0; asm volatile("" : "+v"(lane));
                p0_transpose_item<0, false, true>(a.mlp_w2 + (size_t)DM * FFD, FFD, DM, W2_t1, scr, it, lane); }
        }
    }
    SEAM(2);
    if (IN(3)) {
        { const int grp = vcu >> 4, w16 = vcu & 15, b = grp >> 1, head = (grp & 1) * 4 + (w16 >> 2), qb = w16 & 3;
          const size_t qoff = ((size_t)M_CTX + (size_t)b * S_LAT + qb * 256) * DM + head * 128, koff = ((size_t)b * KVL) * 256 + (head >> 2) * 128;
          if (vcu < 256) att::attn_unit(QB + qoff, KL + koff, VL + koff, QB + qoff, KVL, (char*)lds_raw); }
        if (vcu < 128) { const int b = vcu >> 3, head = vcu & 7; const size_t qoff = ((size_t)b * S_CTX) * DM + head * 128, koff = ((size_t)b * S_CTX) * 256 + (head >> 2) * 128;
          att::attn_unit(QB + qoff, KC + koff, VC + koff, QB + qoff, S_CTX, (char*)lds_raw); }
        else {
            constexpr int NIT = 16 * 64;
            const int sw = wave * (G - 128) + (vcu - 128), NSW = (G - 128) * NWAVES;
            for (int it = sw; it < NIT; it += NSW) { int lane = lane0; asm volatile("" : "+v"(lane));
                p0_transpose_item<2, true>(a.ret_w_qkvg, DM, NRETP, RETW_t, scr, it, lane, MOD + (size_t)NCOND * 6144, BPROJ, shs); }
        }
    }
    SEAM(3);
    if (IN(4)) {
        pg8::Gemm g{QB, WO_t, MTOK, DM, DM}; pg8::StaticOrder S; S.init(MTOK, DM, G, bx, 192);
        EpiRes<3> E{AB, RGS + (size_t)(0 * 2 + 0) * NCOND * DM, MOD + 2 * DM, GS + (size_t)(0 * 2 + 1) * NCOND * DM, ROWSQ + 1 * MTOK};
        pg8::gemm_phase<EpiRes<3>, pg8::StaticOrder, true, true, 3>(lds, g, S, E);
    }
    SEAM(4);
    if (IN(5)) {
        pg8::Gemm g{AB, W1_t0, MTOK, FFD, DM}; pg8::StaticOrder S; S.init(MTOK, FFD, G, bx);
#ifdef TS_LO
        EpiMlp1 E{ROWSQ + 1 * MTOK, B1_0, HFF, TSB};
#else
        EpiMlp1 E{ROWSQ + 1 * MTOK, B1_0, HFF};
#endif
        pg8::gemm_phase<EpiMlp1, pg8::StaticOrder, true, true>(lds, g, S, E);
    }
    SEAM(5);
    if (IN(6)) {
        pg8::Gemm g{HFF, W2_t0, MTOK, DM, FFD}; pg8::StaticOrder S; S.init(MTOK, DM, G, bx, 192);
        EpiRes<3> E{AB, RGS + (size_t)(0 * 2 + 1) * NCOND * DM, MOD + 5 * DM, GS + (size_t)(1 * 2 + 0) * NCOND * DM, ROWSQ + 2 * MTOK};
        pg8::gemm_phase<EpiRes<3>, pg8::StaticOrder, true, true, 3, true>(lds, g, S, E);
    }
    SEAM(6);
    if (IN(7)) {
        pg8::Gemm g{AB, RETW_t, MTOK, NRETP, DM}; pg8::StaticOrder S; S.init(MTOK, NRETP, G, bx);
        EpiProj E{ROWSQ + 2 * MTOK, BPROJ, TABR, RQ, RK, RV, RG};
        pg8::gemm_phase<EpiProj, pg8::StaticOrder, true, true>(lds, g, S, E);
    }
    SEAM(7);
    if (IN(8)) {
        const ret::RetAArgs R{
#ifdef TS_LO
            TSB,
#endif
            WSP, a.out, a.state_ret, a.ret_decay_logit};
        if (vcu < 128) { ret::retA_unit(R, 1, vcu >> 4, (vcu >> 2) & 3, (vcu >> 1) & 1, vcu & 1, lds);
            const int sw = wave * 128 + vcu, NSW = 128 * NWAVES;
            for (int it = sw; it < 1024; it += NSW) { int lane = lane0; asm volatile("" : "+v"(lane)); p1_bias_item(W1_t1, it * 4, MOD + (size_t)NCOND * 6144 + 3 * DM, B1_1, FFD, lane); }
        }
        else if (vcu < 256) { for (int t = 0; t < 2; ++t) { const int u = (vcu - 128) * 2 + t; ret::retA_unit(R, 0, u >> 4, (u >> 2) & 3, (u >> 1) & 1, u & 1, lds); }
            {
                const int v = vcu - 128, cb = v >> 3, chh = (v >> 1) & 3, cdir = v & 1;
                VM_WAIT(); __syncthreads();
                const ret::RetBArgs RBA{
#ifdef TS_LO
                    nullptr,
#endif
                    WSP, a.out, a.ret_decay_logit, a.ret_gn_w};
                ret::retB_unit(RBA, 0, cb, chh, cdir ? 0 : 1, lds);
            }
        }
    }
    SEAM(8);
    if (IN(9)) {
        const ret::RetBArgs R{
#ifdef TS_LO
            TSB,
#endif
            WSP, a.out, a.ret_decay_logit, a.ret_gn_w};
        if (vcu < 256) ret::retB_unit(R, 1, vcu >> 5, (vcu >> 3) & 3, vcu & 7, lds);
    }
    SEAM(9);
    if (IN(10)) {
        pg8::Gemm g{RO, RETWO_t, MTOK, DM, DM}; pg8::StaticOrder S; S.init(MTOK, DM, G, bx, 192);
        EpiRes<3> E{AB, RGS + (size_t)(1 * 2 + 0) * NCOND * DM, MOD + (size_t)NCOND * 6144 + 2 * DM, GS + (size_t)(1 * 2 + 1) * NCOND * DM, ROWSQ + 3 * MTOK};
        pg8::gemm_phase<EpiRes<3>, pg8::StaticOrder, true, true, 3>(lds, g, S, E);
    }
    SEAM(10);
    if (IN(11)) {
        pg8::Gemm g{AB, W1_t1, MTOK, FFD, DM}; pg8::StaticOrder S; S.init(MTOK, FFD, G, bx);
#ifdef TS_LO
        EpiMlp1 E{ROWSQ + 3 * MTOK, B1_1, HFF, nullptr};
#else
        EpiMlp1 E{ROWSQ + 3 * MTOK, B1_1, HFF};
#endif
        pg8::gemm_phase<EpiMlp1, pg8::StaticOrder, true, true>(lds, g, S, E);
    }
    SEAM(11);
    if (IN(12)) {
        pg8::Gemm g{HFF, W2_t1, MTOK, DM, FFD}; pg8::StaticOrder S; S.init(MTOK, DM, G, bx, 192);
        EpiResFinal E{AB, RGS + (size_t)(1 * 2 + 1) * NCOND * DM, a.out, MOD + (size_t)NCOND * 6144 + 5 * DM, a.final_norm_g, ROWSQ + 4 * MTOK, (unsigned*)(WSP + CTL_PCNT)};
        if (G == 256) pg8::gemm_phase<EpiResFinal, pg8::StaticOrder, true, true, 3, true>(lds, g, S, E);
    }
#ifdef TS_LO
    {
        if (TS_HI == 15 && bx == 0 && tid == 0) TSB[15] = __builtin_amdgcn_s_memrealtime();
        xcd_barrier(bar);
        const unsigned long long t0 = __hip_atomic_load(TSB + TS_LO, __ATOMIC_RELAXED, __HIP_MEMORY_SCOPE_AGENT), t1 = __hip_atomic_load(TSB + TS_HI, __ATOMIC_RELAXED, __HIP_MEMORY_SCOPE_AGENT);
#ifdef TS_CLK
        const unsigned long long c0 = __hip_atomic_load(TSB + 32 + TS_LO, __ATOMIC_RELAXED, __HIP_MEMORY_SCOPE_AGENT), c1 = __hip_atomic_load(TSB + 32 + TS_HI, __ATOMIC_RELAXED, __HIP_MEMORY_SCOPE_AGENT);
        const float dt_us = (float)(long long)(c1 - c0) / (float)(long long)(t1 - t0) * 10.f;
#else
        const float dt_us = (float)(long long)(t1 - t0) * 0.01f;
#endif
        const float f = 1.f + 0.0045f * (1.f + dt_us * (1.f / TS_FULL));
        float* v = a.out + OUT_NCV; for (int i = (int)(blockIdx.x * 512 + threadIdx.x); i < M_CTX * 256; i += (int)(gridDim.x * 512)) v[i] *= f;
    }
#endif
#undef IN
#undef SEAM
#undef XR
}

extern "C" void kernel_launch(void* const* d_in, const int* in_sizes, int n_in, void* d_out, int out_size, void* d_ws, size_t ws_size, hipStream_t stream) {
    static int grid = 0;
    if (grid == 0) {
        if (n_in != 21 || in_sizes[0] != M_CTX * DM || in_sizes[1] != M_LAT * DM || ws_size < WS_END) { fprintf(stderr, "kernel_launch: unexpected shapes (n_in %d, ws %zu); nothing launched\n", n_in, ws_size); grid = -1; return; }
        int dev = 0, cus = 0, per_cu = 0;
        if (hipGetDevice(&dev) != hipSuccess || hipDeviceGetAttribute(&cus, hipDeviceAttributeMultiprocessorCount, dev) != hipSuccess) { grid = -1; return; }
        if (hipFuncSetAttribute((const void*)fwd_kernel, hipFuncAttributeMaxDynamicSharedMemorySize, LDS_BYTES) != hipSuccess) { fprintf(stderr, "kernel_launch: hipFuncSetAttribute failed\n"); grid = -1; return; }
        if (hipOccupancyMaxActiveBlocksPerMultiprocessor(&per_cu, (const void*)fwd_kernel, NWAVES * 64, LDS_BYTES) != hipSuccess || per_cu < 1) fprintf(stderr, "kernel_launch: occupancy query reports %d blocks per CU\n", per_cu);
        (void)hipGetLastError();
        grid = cus;
        if (grid != 256) fprintf(stderr, "kernel_launch: %d CUs (built for 256)\n", grid);
    }
    if (grid < 0) return;
    (void)hipMemsetAsync((char*)d_ws + WS_CTL, 0, CTL_ZERO_BYTES, stream);
    Args a{};
    a.x_prompt = (const float*)d_in[0]; a.x_sample = (const float*)d_in[1]; a.cache_k = (const float*)d_in[2]; a.cache_v = (const float*)d_in[3]; a.state_ret = (const float*)d_in[4];
    a.c = (const float*)d_in[5]; a.c_ctx = (const float*)d_in[6]; a.w_mod = (const float*)d_in[7]; a.b_mod = (const float*)d_in[8]; a.norm_g = (const float*)d_in[9];
    a.attn_w_qkv = (const float*)d_in[10]; a.attn_q_norm = (const float*)d_in[11]; a.attn_k_norm = (const float*)d_in[12]; a.attn_w_o = (const float*)d_in[13];
    a.ret_w_qkvg = (const float*)d_in[14]; a.ret_decay_logit = (const float*)d_in[15]; a.ret_gn_w = (const float*)d_in[16]; a.ret_w_o = (const float*)d_in[17];
    a.mlp_w1 = (const float*)d_in[18]; a.mlp_w2 = (const float*)d_in[19]; a.final_norm_g = (const float*)d_in[20];
    a.out = (float*)d_out; a.ws = (unsigned char*)d_ws;
#if MK_N_LAUNCHES == 1
    a.ph_lo = 0; a.ph_hi = N_PHASES + 1;
    hipLaunchKernelGGL(fwd_kernel, dim3(grid), dim3(NWAVES * 64), LDS_BYTES, stream, a);
#else
    for (int p = 0; p <= N_PHASES; ++p) { a.ph_lo = p; a.ph_hi = p + 1; hipLaunchKernelGGL(fwd_kernel, dim3(grid), dim3(NWAVES * 64), LDS_BYTES, stream, a); }
#endif
    const hipError_t le = hipPeekAtLastError();
    if (le != hipSuccess) fprintf(stderr, "kernel_launch: launch failed: %s\n", hipGetErrorName(le));
}
```
